# Optimizing an MI355X kernel written in HIP

```python
import jax, jax.numpy as jnp
from jax import lax
import numpy as np

D_MODEL = 2048
BATCH = 4
SEQ = 2048
DEPTH = 4

CHUNK = 64
Q_BLOCK = 128
N_MIXERS = 3
N_MLA_LAYERS = (DEPTH + 2) // 3
N_SB_LAYERS = (DEPTH + 1) // 3
N_CA_LAYERS = DEPTH // 3

MLA_HEADS = 16
MLA_Q_LORA = 512
MLA_KV_LORA = 512
MLA_NOPE = 128
MLA_ROPE = 64
MLA_V = 128
ROPE_THETA = 10000.0

SB_HEADS = 16
SB_HEAD_DIM = 128

CA_HEADS = 16
CA_HEAD_DIM = 128
CA_LEFT_CHUNKS = 8
REL_CLIP_LEFT = 128
REL_TABLE = REL_CLIP_LEFT + CHUNK

D_FF = 4 * D_MODEL

LN_EPS = 1e-5
RMS_EPS = 1e-6
DEEPNORM_ALPHA = (2.0 * DEPTH) ** 0.25
DEEPNORM_BETA = (8.0 * DEPTH) ** -0.25
NEG = -1e30

kernel_name = "hybrid_streaming_mla_stickbreak_chunkrel_deepnorm"


def layer_norm(x, g, b):
    xf = x.astype(jnp.float32)
    mu = jnp.mean(xf, -1, keepdims=True)
    var = jnp.mean(jnp.square(xf - mu), -1, keepdims=True)
    return ((xf - mu) * lax.rsqrt(var + LN_EPS) * g.astype(jnp.float32) + b.astype(jnp.float32)).astype(x.dtype)


def rms_norm(x, g):
    xf = x.astype(jnp.float32)
    return (xf * lax.rsqrt(jnp.mean(xf * xf, -1, keepdims=True) + RMS_EPS) * g.astype(jnp.float32)).astype(x.dtype)


def rope(x, pos):
    half = x.shape[-1] // 2
    inv = ROPE_THETA ** (-jnp.arange(half, dtype=jnp.float32) / half)
    ang = pos.astype(jnp.float32)[:, None] * inv[None, :]
    cos = jnp.cos(ang)[None, :, None, :]
    sin = jnp.sin(ang)[None, :, None, :]
    x1 = x[..., :half].astype(jnp.float32)
    x2 = x[..., half:].astype(jnp.float32)
    return jnp.concatenate([x1 * cos - x2 * sin, x2 * cos + x1 * sin], -1).astype(x.dtype)


def mla_mixer(x, w_down, q_norm_g, w_uq, kv_norm_g, w_ukv, w_o):
    B, S, _ = x.shape
    H = MLA_HEADS
    down = x @ w_down
    c_q, c_kv, k_rope = jnp.split(down, [MLA_Q_LORA, MLA_Q_LORA + MLA_KV_LORA], axis=-1)
    q = (rms_norm(c_q, q_norm_g) @ w_uq).reshape(B, S, H, MLA_NOPE + MLA_ROPE)
    kv = (rms_norm(c_kv, kv_norm_g) @ w_ukv).reshape(B, S, H, MLA_NOPE + MLA_V)
    q_nope, q_rope = q[..., :MLA_NOPE], q[..., MLA_NOPE:]
    k_nope, v = kv[..., :MLA_NOPE], kv[..., MLA_NOPE:]
    pos = jnp.arange(S)
    q_rope = rope(q_rope, pos)
    k_rope = rope(k_rope[:, :, None, :], pos)[:, :, 0, :]
    scale = (MLA_NOPE + MLA_ROPE) ** -0.5
    chunk_id = pos // CHUNK
    outs = []
    for qs in range(0, S, Q_BLOCK):
        ke = qs + Q_BLOCK
        s = (jnp.einsum('bqhd,bkhd->bhqk', q_nope[:, qs:ke], k_nope[:, :ke])
             + jnp.einsum('bqhr,bkr->bhqk', q_rope[:, qs:ke], k_rope[:, :ke])).astype(jnp.float32) * scale
        mask = chunk_id[None, :ke] <= chunk_id[qs:ke, None]
        p = jax.nn.softmax(jnp.where(mask, s, NEG), axis=-1).astype(v.dtype)
        outs.append(jnp.einsum('bhqk,bkhd->bqhd', p, v[:, :ke]))
    o = jnp.concatenate(outs, axis=1).reshape(B, S, H * MLA_V)
    return o @ w_o


def stick_breaking_mixer(x, w_qkv, w_o):
    B, S, _ = x.shape
    H, Dh = SB_HEADS, SB_HEAD_DIM
    q, k, v = jnp.split((x @ w_qkv).reshape(B, S, 3, H, Dh), 3, axis=2)
    q, k, v = q[:, :, 0], k[:, :, 0], v[:, :, 0]
    scale = Dh ** -0.5
    pos = jnp.arange(S)
    outs = []
    for qs in range(0, S, Q_BLOCK):
        ke = qs + Q_BLOCK
        z = jnp.einsum('bqhd,bkhd->bhqk', q[:, qs:ke], k[:, :ke]).astype(jnp.float32) * scale
        strict = pos[None, :ke] < pos[qs:ke, None]
        log_beta = jax.nn.log_sigmoid(z)
        log_1m = jnp.where(strict, jax.nn.log_sigmoid(-z), 0.0)
        log_surv = lax.cumsum(log_1m, axis=3, reverse=True) - log_1m
        a = jnp.where(strict, jnp.exp(log_beta + log_surv), 0.0).astype(v.dtype)
        outs.append(jnp.einsum('bhqk,bkhd->bqhd', a, v[:, :ke]))
    o = jnp.concatenate(outs, axis=1).reshape(B, S, H * Dh)
    return o @ w_o


def chunked_relpos_mixer(x, w_qkv, rel_bias, w_o):
    B, S, _ = x.shape
    H, Dh = CA_HEADS, CA_HEAD_DIM
    n_chunks = S // CHUNK
    pad = CA_LEFT_CHUNKS * CHUNK
    band = pad + CHUNK
    q, k, v = jnp.split((x @ w_qkv).reshape(B, S, 3, H, Dh), 3, axis=2)
    q, k, v = q[:, :, 0], k[:, :, 0], v[:, :, 0]
    qc = q.reshape(B, n_chunks, CHUNK, H, Dh)
    k_pad = jnp.pad(k, ((0, 0), (pad, 0), (0, 0), (0, 0)))
    v_pad = jnp.pad(v, ((0, 0), (pad, 0), (0, 0), (0, 0)))
    key_idx = jnp.arange(n_chunks)[:, None] * CHUNK + jnp.arange(band)[None, :]
    kb = k_pad[:, key_idx]
    vb = v_pad[:, key_idx]
    s = jnp.einsum('bcqhd,bckhd->bhcqk', qc, kb).astype(jnp.float32) * (Dh ** -0.5)
    rel = jnp.arange(band)[None, :] - pad - jnp.arange(CHUNK)[:, None]
    bias = rel_bias[jnp.clip(rel, -REL_CLIP_LEFT, CHUNK - 1) + REL_CLIP_LEFT]
    s = s + jnp.transpose(bias, (2, 0, 1)).astype(jnp.float32)[None, :, None]
    valid = (key_idx - pad) >= 0
    s = jnp.where(valid[None, None, :, None, :], s, NEG)
    p = jax.nn.softmax(s, axis=-1).astype(vb.dtype)
    o = jnp.einsum('bhcqk,bckhd->bcqhd', p, vb).reshape(B, S, H * Dh)
    return o @ w_o


def sq_relu_mlp(x, w_in, w_out):
    return jnp.square(jax.nn.relu(x @ w_in)) @ w_out


def setup_inputs(seed: int = 0) -> dict:
    key = jax.random.key(seed)
    keys = iter(jax.random.split(key, 32))

    def nrm(shape, scale):
        return jax.random.normal(next(keys), shape, jnp.float32) * scale

    x = nrm((BATCH, SEQ, D_MODEL), 1.0)
    ln_mix_g = 1.0 + nrm((DEPTH, D_MODEL), 0.02)
    ln_mix_b = nrm((DEPTH, D_MODEL), 0.02)
    ln_ffn_g = 1.0 + nrm((DEPTH, D_MODEL), 0.02)
    ln_ffn_b = nrm((DEPTH, D_MODEL), 0.02)
    ffn_w_in = nrm((DEPTH, D_MODEL, D_FF), D_MODEL ** -0.5 * DEEPNORM_BETA)
    ffn_w_out = nrm((DEPTH, D_FF, D_MODEL), D_FF ** -0.5 * DEEPNORM_BETA)

    nA = N_MLA_LAYERS
    mla_w_down = nrm((nA, D_MODEL, MLA_Q_LORA + MLA_KV_LORA + MLA_ROPE), D_MODEL ** -0.5)
    mla_q_norm_g = 1.0 + nrm((nA, MLA_Q_LORA), 0.02)
    mla_w_uq = nrm((nA, MLA_Q_LORA, MLA_HEADS * (MLA_NOPE + MLA_ROPE)), MLA_Q_LORA ** -0.5)
    mla_kv_norm_g = 1.0 + nrm((nA, MLA_KV_LORA), 0.02)
    w_uk = nrm((nA, MLA_KV_LORA, MLA_HEADS, MLA_NOPE), MLA_KV_LORA ** -0.5)
    w_uv = nrm((nA, MLA_KV_LORA, MLA_HEADS, MLA_V), MLA_KV_LORA ** -0.5 * DEEPNORM_BETA)
    mla_w_ukv = jnp.concatenate([w_uk, w_uv], -1).reshape(nA, MLA_KV_LORA, MLA_HEADS * (MLA_NOPE + MLA_V))
    mla_w_o = nrm((nA, MLA_HEADS * MLA_V, D_MODEL), (MLA_HEADS * MLA_V) ** -0.5 * DEEPNORM_BETA)

    nB = N_SB_LAYERS
    sb_qk = nrm((nB, D_MODEL, 2, SB_HEADS * SB_HEAD_DIM), D_MODEL ** -0.5)
    sb_v = nrm((nB, D_MODEL, 1, SB_HEADS * SB_HEAD_DIM), D_MODEL ** -0.5 * DEEPNORM_BETA)
    sb_w_qkv = jnp.concatenate([sb_qk, sb_v], 2).reshape(nB, D_MODEL, 3 * SB_HEADS * SB_HEAD_DIM)
    sb_w_o = nrm((nB, SB_HEADS * SB_HEAD_DIM, D_MODEL), (SB_HEADS * SB_HEAD_DIM) ** -0.5 * DEEPNORM_BETA)

    nC = N_CA_LAYERS
    ca_qk = nrm((nC, D_MODEL, 2, CA_HEADS * CA_HEAD_DIM), D_MODEL ** -0.5)
    ca_v = nrm((nC, D_MODEL, 1, CA_HEADS * CA_HEAD_DIM), D_MODEL ** -0.5 * DEEPNORM_BETA)
    ca_w_qkv = jnp.concatenate([ca_qk, ca_v], 2).reshape(nC, D_MODEL, 3 * CA_HEADS * CA_HEAD_DIM)
    ca_rel_bias = nrm((nC, REL_TABLE, CA_HEADS), 0.5)
    ca_w_o = nrm((nC, CA_HEADS * CA_HEAD_DIM, D_MODEL), (CA_HEADS * CA_HEAD_DIM) ** -0.5 * DEEPNORM_BETA)

    return {"x": x, "ln_mix_g": ln_mix_g, "ln_mix_b": ln_mix_b, "ln_ffn_g": ln_ffn_g, "ln_ffn_b": ln_ffn_b,
            "ffn_w_in": ffn_w_in, "ffn_w_out": ffn_w_out,
            "mla_w_down": mla_w_down, "mla_q_norm_g": mla_q_norm_g, "mla_w_uq": mla_w_uq,
            "mla_kv_norm_g": mla_kv_norm_g, "mla_w_ukv": mla_w_ukv, "mla_w_o": mla_w_o,
            "sb_w_qkv": sb_w_qkv, "sb_w_o": sb_w_o,
            "ca_w_qkv": ca_w_qkv, "ca_rel_bias": ca_rel_bias, "ca_w_o": ca_w_o}


def reference(x, ln_mix_g, ln_mix_b, ln_ffn_g, ln_ffn_b, ffn_w_in, ffn_w_out,
              mla_w_down, mla_q_norm_g, mla_w_uq, mla_kv_norm_g, mla_w_ukv, mla_w_o,
              sb_w_qkv, sb_w_o, ca_w_qkv, ca_rel_bias, ca_w_o):
    h = x
    for i in range(DEPTH):
        kind = i % N_MIXERS
        slot = i // N_MIXERS
        if kind == 0:
            m = mla_mixer(h, mla_w_down[slot], mla_q_norm_g[slot], mla_w_uq[slot],
                          mla_kv_norm_g[slot], mla_w_ukv[slot], mla_w_o[slot])
        elif kind == 1:
            m = stick_breaking_mixer(h, sb_w_qkv[slot], sb_w_o[slot])
        else:
            m = chunked_relpos_mixer(h, ca_w_qkv[slot], ca_rel_bias[slot], ca_w_o[slot])
        h = layer_norm(DEEPNORM_ALPHA * h + m, ln_mix_g[i], ln_mix_b[i])
        h = layer_norm(DEEPNORM_ALPHA * h + sq_relu_mlp(h, ffn_w_in[i], ffn_w_out[i]),
                       ln_ffn_g[i], ln_ffn_b[i])
    return h
```

```cpp
#include <hip/hip_runtime.h>
#include <hip/hip_cooperative_groups.h>
#include <cstdio>
namespace cg = cooperative_groups;

#define LAS __attribute__((address_space(3)))
typedef unsigned short bf16_t;
typedef short bf16x8 __attribute__((ext_vector_type(8)));
typedef short s16x4 __attribute__((ext_vector_type(4)));
typedef float f32x4 __attribute__((ext_vector_type(4)));
typedef float f32x16 __attribute__((ext_vector_type(16)));
typedef unsigned u32x4 __attribute__((ext_vector_type(4)));
typedef unsigned u32x2 __attribute__((ext_vector_type(2)));

constexpr int T_ = 8192, DM = 2048, DFF = 8192, SEQ = 2048;
constexpr float ALPHA = 1.6817928305074290f;
constexpr float LN_EPS = 1e-5f, RMS_EPS = 1e-6f;
constexpr float LOG2E = 1.4426950408889634f;

constexpr size_t MB = 1ull << 20;
constexpr size_t OFF_WFI = 0, OFF_WFO = 128 * MB, OFF_MLA = 256 * MB, OFF_SB = 296 * MB, OFF_CA = 328 * MB, OFF_VEC = 360 * MB,
                 OFF_STATS = 361 * MB, OFF_ROPE = 363 * MB, OFF_Y = 364 * MB, OFF_YB = 428 * MB, OFF_QKV = 460 * MB, OFF_O = 600 * MB,
                 OFF_HID = 632 * MB, WS_END = 760 * MB;
constexpr size_t OFF_BAR = OFF_STATS + 3 * MB / 2;
constexpr int XB_ST_OFF = 155648 - 16;
constexpr size_t MLA_SLOT = 20 * MB, MLA_DOWN = 0, MLA_UQ = 5 * MB, MLA_UKV = 8 * MB, MLA_WO = 12 * MB;
constexpr size_t QKV_DOWN = 0, QKV_Q = 20 * MB, QKV_KV = 68 * MB, QKV_KR = 132 * MB;
constexpr int V_FI_CS = 0, V_FI_BW = 4 * 8192, V_MD_CS = 8 * 8192, V_MD_BW = V_MD_CS + 2 * 1280, V_SB_CS = V_MD_BW + 2 * 1280, V_SB_BW = V_SB_CS + 6144,
              V_CA_CS = V_SB_BW + 6144, V_CA_BW = V_CA_CS + 6144;
constexpr int ST_ROWSS = 8 * T_ * 2, ST_TOTAL = 10 * T_ * 2;

struct WDesc { const float* W; bf16_t* WT; const float* g; const float* bvec; float* csum; float* bw; int K, N, Npad, kchunk, item0, nitems; };
struct Params {
    const float* in[18];
    float* out; unsigned char* ws;
    WDesc wd[20];
    int nwd, total_items, ph_lo, ph_hi;
    unsigned char prog[48];
};

__device__ __forceinline__ unsigned cvt_pk_bf16(float lo, float hi) { unsigned r; asm volatile("v_cvt_pk_bf16_f32 %0, %1, %2" : "=v"(r) : "v"(lo), "v"(hi)); return r; }
__device__ __forceinline__ int ltid() { int t = threadIdx.x; asm volatile("" : "+v"(t)); return t; }
__device__ __forceinline__ int lgdim() { int t = gridDim.x; asm volatile("" : "+s"(t)); return t; }
__device__ __forceinline__ int lbid() { int t = blockIdx.x; asm volatile("" : "+s"(t)); return t; }
typedef long long i64;
__device__ __forceinline__ i64 to_fx(float v) { const float fl = floorf(v); const unsigned lo = (unsigned)((v - fl) * 4294967296.0f); return (i64)(((unsigned long long)(unsigned)(int)fl << 32) | lo); }
__device__ __forceinline__ float from_fx(i64 v, float scale) { const int hi = (int)(v >> 32); const unsigned lo = (unsigned)v; return ((float)hi + (float)lo * 2.3283064365386963e-10f) * scale; }
__device__ __forceinline__ void fx_add(i64* p, float v) { atomicAdd((unsigned long long*)p, (unsigned long long)to_fx(v)); }
__device__ __forceinline__ float bf_lo(unsigned u) { return __uint_as_float(u << 16); }
__device__ __forceinline__ float bf_hi(unsigned u) { return __uint_as_float(u & 0xffff0000u); }

namespace pg8 {
constexpr int BM = 256, BK = 64, HALF = 128, HTB = HALF * BK * 2, STAGE_BYTES = 8 * HTB, NXCD = 8, WGM = 8;
__host__ __device__ __forceinline__ int lds_byte(int r, int c) { const int st = (r >> 4) * 2 + (c >> 5), rr = r & 15, cc = c & 31, ob = rr * 64 + cc * 2; return st * 1024 + (ob ^ (((ob >> 9) & 1) << 5)); }
__host__ __device__ __forceinline__ void stage_rc(int b, int& R, int& C) { const int st = b / 1024, sb = b % 1024, swz = sb ^ (((sb >> 9) & 1) << 5); R = (st >> 1) * 16 + swz / 64; C = (st & 1) * 32 + (swz % 64) / 2; }
__host__ __device__ __forceinline__ int perm32(int rho) { const int n = rho >> 4, i = rho & 15; return 8 * (i >> 2) + 4 * n + (i & 3); }
struct Unit { int pm, pn; };
struct Gemm { const bf16_t* A; const bf16_t* Bt; int M, N, K, lda; };
struct StaticOrder {
    int nM, nN, nwg, G, c;
    __device__ void init(int M, int N, int G_, int c_) { nM = M / BM; nN = N / BM; nwg = nM * nN; G = G_; c = c_; }
    __device__ bool next(int i, Unit& u) const {
        const long L = (long)i * G + c; if (L >= nwg) return false;
        int wgid = (int)L; { const int q = nwg / NXCD, r = nwg % NXCD, xcd = wgid % NXCD, off = wgid / NXCD; wgid = (xcd < r ? xcd * (q + 1) : r * (q + 1) + (xcd - r) * q) + off; }
        const int nig = WGM * nN, gid = wgid / nig, fm = gid * WGM, gsz = (nM - fm) < WGM ? (nM - fm) : WGM;
        u.pm = fm + ((wgid % nig) % gsz); u.pn = (wgid % nig) / gsz; return true;
    }
};

template <class Epi>
__device__ __forceinline__ void gemm_phase(LAS unsigned char* lds, const Gemm g, const StaticOrder& S, const Epi& E) {
    int tid = threadIdx.x; asm volatile("" : "+v"(tid));
    const int wid = __builtin_amdgcn_readfirstlane(tid >> 6), lane = tid & 63, wr = wid >> 2, wc = wid & 3, fr = lane & 15, fq = lane >> 4;
    const int K = g.K, nt = K / BK, lda = g.lda;
    unsigned voffA[2], voffB[2];
#pragma unroll
    for (int i = 0; i < 2; ++i) { int R, C; stage_rc(tid * 16 + i * 8192, R, C); const int Rb = Epi::PERM ? ((R & ~31) + perm32(R & 31)) : R;
        voffA[i] = (unsigned)(R * lda + C) * 2u; voffB[i] = (unsigned)(Rb * K + C) * 2u; }
    const size_t kstep = (size_t)(BK * 2);
    const size_t hstepA = (size_t)HALF * lda * 2, hstepB = (size_t)HALF * K * 2;
    const size_t tstepA = 2 * hstepA, tstepB = 2 * hstepB;
    const unsigned ldsw = (unsigned)wid * 1024u;
    const int aoff = lds_byte(wr * 64 + fr, fq * 8), boff = lds_byte(wc * 32 + fr, fq * 8);
#define PG8_SA(b, h) (((b) * 2 + (h)) * HTB)
#define PG8_SB(b, h) ((4 + (b) * 2 + (h)) * HTB)
#define PG8_STAGE(bufoff, gbase, voff) do { _Pragma("unroll") for (int _i = 0; _i < 2; ++_i) \
        __builtin_amdgcn_global_load_lds((const unsigned*)((const char*)(gbase) + (voff)[_i]), (LAS unsigned*)(lds + (bufoff) + ldsw + _i * 8192), 16, 0, 0); } while (0)
#define PG8_LDA(dst, b, h) do { _Pragma("unroll") for (int m = 0; m < 4; ++m) _Pragma("unroll") for (int k = 0; k < 2; ++k) dst[m][k] = *(const LAS bf16x8*)(lds + PG8_SA(b, h) + aoff + m * 2048 + k * 1024); } while (0)
#define PG8_LDB(dst, b, h) do { _Pragma("unroll") for (int n = 0; n < 2; ++n) _Pragma("unroll") for (int k = 0; k < 2; ++k) dst[n][k] = *(const LAS bf16x8*)(lds + PG8_SB(b, h) + boff + n * 2048 + k * 1024); } while (0)
#define PG8_MMA(ai, bj, At, Bt) do { __builtin_amdgcn_s_setprio(1); _Pragma("unroll") for (int m = 0; m < 4; ++m) _Pragma("unroll") for (int n = 0; n < 2; ++n) _Pragma("unroll") for (int k = 0; k < 2; ++k) \
        acc[ai][bj][m][n] = __builtin_amdgcn_mfma_f32_16x16x32_bf16(Bt[n][k], At[m][k], acc[ai][bj][m][n], 0, 0, 0); __builtin_amdgcn_s_setprio(0); } while (0)
#define PG8_WAIT_V(n) asm volatile("s_waitcnt vmcnt(" #n ")" ::: "memory")
#define PG8_WAIT_L(n) asm volatile("s_waitcnt lgkmcnt(" #n ")" ::: "memory")
#define PG8_BAR __builtin_amdgcn_s_barrier()
#define PG8_SCHED __builtin_amdgcn_sched_barrier(0)
    Unit cur, nxt; int ui = 0;
    if (!S.next(0, cur)) return;
    f32x4 acc[2][2][4][2];
#pragma unroll
    for (int a = 0; a < 2; ++a)
#pragma unroll
        for (int b = 0; b < 2; ++b)
#pragma unroll
            for (int m = 0; m < 4; ++m)
#pragma unroll
                for (int n = 0; n < 2; ++n) acc[a][b][m][n] = (f32x4){0.f, 0.f, 0.f, 0.f};
    bf16x8 At[4][2], B0[2][2], B1[2][2];
    const char* cA = (const char*)g.A + (size_t)cur.pm * tstepA; const char* cB = (const char*)g.Bt + (size_t)cur.pn * tstepB;
    PG8_STAGE(PG8_SB(0, 0), cB, voffB); PG8_STAGE(PG8_SA(0, 0), cA, voffA); PG8_STAGE(PG8_SB(0, 1), cB + hstepB, voffB); PG8_STAGE(PG8_SA(0, 1), cA + hstepA, voffA);
    if (wr == 1) PG8_BAR;
    PG8_WAIT_V(4); PG8_BAR;
    PG8_STAGE(PG8_SB(1, 0), cB + kstep, voffB); PG8_STAGE(PG8_SA(1, 0), cA + kstep, voffA); PG8_STAGE(PG8_SB(1, 1), cB + hstepB + kstep, voffB);
    PG8_WAIT_V(6); PG8_BAR;
    for (;;) {
        const bool has_next = S.next(ui + 1, nxt);
        const char* nA = has_next ? (const char*)g.A + (size_t)nxt.pm * tstepA : cA; const char* nB = has_next ? (const char*)g.Bt + (size_t)nxt.pn * tstepB : cB;
        for (int t = 0; t < nt; t += 2) {
            const bool last = (t == nt - 2);
            const char* a1 = cA + (size_t)(t + 1) * kstep;
            const char* a2 = last ? nA : cA + (size_t)(t + 2) * kstep; const char* b2 = last ? nB : cB + (size_t)(t + 2) * kstep;
            const char* a3 = a2 + kstep; const char* b3 = b2 + kstep;
            PG8_LDB(B0, 0, 0); PG8_SCHED; PG8_LDA(At, 0, 0); PG8_STAGE(PG8_SA(1, 1), a1 + hstepA, voffA);
            PG8_WAIT_L(8); PG8_BAR; PG8_WAIT_L(0); PG8_MMA(0, 0, At, B0); PG8_BAR; PG8_SCHED;
            PG8_LDB(B1, 0, 1); PG8_STAGE(PG8_SB(0, 0), b2, voffB);
            PG8_BAR; PG8_WAIT_L(0); PG8_MMA(0, 1, At, B1); PG8_BAR;
            PG8_LDA(At, 0, 1); PG8_STAGE(PG8_SA(0, 0), a2, voffA);
            PG8_BAR; PG8_WAIT_L(0); PG8_MMA(1, 0, At, B0); PG8_BAR; PG8_SCHED;
            PG8_STAGE(PG8_SB(0, 1), b2 + hstepB, voffB);
            PG8_WAIT_V(6); PG8_BAR; PG8_MMA(1, 1, At, B1); PG8_BAR;
            PG8_LDB(B0, 1, 0); PG8_SCHED; PG8_LDA(At, 1, 0); PG8_STAGE(PG8_SA(0, 1), a2 + hstepA, voffA);
            PG8_WAIT_L(8); PG8_BAR; PG8_WAIT_L(0); PG8_MMA(0, 0, At, B0); PG8_BAR; PG8_SCHED;
            PG8_LDB(B1, 1, 1); PG8_STAGE(PG8_SB(1, 0), b3, voffB);
            PG8_BAR; PG8_WAIT_L(0); PG8_MMA(0, 1, At, B1); PG8_BAR;
            PG8_LDA(At, 1, 1); PG8_STAGE(PG8_SA(1, 0), a3, voffA);
            PG8_BAR; PG8_WAIT_L(0); PG8_MMA(1, 0, At, B0); PG8_BAR; PG8_SCHED;
            PG8_STAGE(PG8_SB(1, 1), b3 + hstepB, voffB);
            PG8_WAIT_V(6); PG8_BAR; PG8_MMA(1, 1, At, B1); PG8_BAR;
        }
        E(acc, cur, wr, wc, fr, fq);
        if (!has_next) break;
#pragma unroll
        for (int a = 0; a < 2; ++a)
#pragma unroll
            for (int b = 0; b < 2; ++b)
#pragma unroll
                for (int m = 0; m < 4; ++m)
#pragma unroll
                    for (int n = 0; n < 2; ++n) acc[a][b][m][n] = (f32x4){0.f, 0.f, 0.f, 0.f};
        cur = nxt; cA = nA; cB = nB; ++ui;
    }
    PG8_WAIT_V(0);
    if (wr == 0) PG8_BAR;
    PG8_BAR;
#undef PG8_SA
#undef PG8_SB
#undef PG8_STAGE
#undef PG8_LDA
#undef PG8_LDB
#undef PG8_MMA
#undef PG8_WAIT_V
#undef PG8_WAIT_L
#undef PG8_BAR
#undef PG8_SCHED
}
}

template <int LNF, int ACT> struct EpiProj {
    static constexpr bool PERM = true;
    bf16_t* O; int ldc; const i64* stats; int ss_idx; const float* csum; const float* bw; i64* ssq;
    __device__ __forceinline__ void operator()(const f32x4 (&acc)[2][2][4][2], const pg8::Unit& u, int wr, int wc, int fr, int fq) const {
        const int row0 = u.pm * 256 + wr * 64 + fr, col0 = u.pn * 256 + wc * 32 + 8 * fq;
        const bool ln = (LNF == 0) && (stats != nullptr);
        typedef long long i64x2 __attribute__((ext_vector_type(2)));
        f32x4 cs[2][2], bv[2][2];
#pragma unroll
        for (int bj = 0; bj < 2; ++bj)
#pragma unroll
            for (int n = 0; n < 2; ++n) {
                cs[bj][n] = ln ? *(const f32x4*)(csum + col0 + bj * 128 + 4 * n) : (f32x4){0.f, 0.f, 0.f, 0.f};
                bv[bj][n] = ln ? *(const f32x4*)(bw + col0 + bj * 128 + 4 * n) : (f32x4){0.f, 0.f, 0.f, 0.f}; }
#pragma unroll
        for (int ai = 0; ai < 2; ++ai) {
            float mu_[4], rs_[4];
#pragma unroll
            for (int i = 0; i < 4; ++i) { const int row = row0 + ai * 128 + i * 16; mu_[i] = 0.f; rs_[i] = 1.f;
                if (LNF == 2 || ln) { const i64x2 sq = *(const i64x2*)(stats + row * 2);
                    if (LNF == 0) { mu_[i] = from_fx(sq[0], 1.f / DM); const float var = from_fx(sq[1], 1.f / DM) - mu_[i] * mu_[i]; rs_[i] = rsqrtf(var + LN_EPS); }
                    else rs_[i] = rsqrtf(from_fx(ss_idx ? sq[1] : sq[0], 1.f / 512.f) + RMS_EPS); } }
#pragma unroll
            for (int m = 0; m < 4; ++m) {
                const int row = row0 + ai * 128 + m * 16;
                const float rs = rs_[m], mu = mu_[m];
                float ssum = 0.f;
                bf16_t* rowp = O + (size_t)row * ldc + col0;
#pragma unroll
                for (int bj = 0; bj < 2; ++bj) {
                    f32x4 v0 = acc[ai][bj][m][0], v1 = acc[ai][bj][m][1];
                    if (LNF == 0) { v0 = rs * (v0 - mu * cs[bj][0]) + bv[bj][0]; v1 = rs * (v1 - mu * cs[bj][1]) + bv[bj][1]; }
                    else { v0 = rs * v0; v1 = rs * v1; }
                    if (ACT == 1) {
#pragma unroll
                        for (int j = 0; j < 4; ++j) { float a = fmaxf(v0[j], 0.f), b = fmaxf(v1[j], 0.f); v0[j] = a * a; v1[j] = b * b; } }
                    if (LNF == 0 && ACT == 0) {
#pragma unroll
                        for (int j = 0; j < 4; ++j) ssum += v0[j] * v0[j] + v1[j] * v1[j]; }
                    u32x4 w; w.x = cvt_pk_bf16(v0[0], v0[1]); w.y = cvt_pk_bf16(v0[2], v0[3]); w.z = cvt_pk_bf16(v1[0], v1[1]); w.w = cvt_pk_bf16(v1[2], v1[3]);
                    *(u32x4*)(rowp + bj * 128) = w; }
                if (LNF == 0 && ACT == 0) { if (ssq != nullptr) {
                    ssum += __shfl_xor(ssum, 16); ssum += __shfl_xor(ssum, 32);
                    if (fq == 0 && u.pn < 4) fx_add(ssq + row * 2 + (u.pn >> 1), ssum); } }
            }
        }
    }
};
struct EpiRes {
    static constexpr bool PERM = true;
    const float* src; float* Y; bf16_t* YB; const i64* stats_prev; const float* g; const float* b; i64* stats_new;
    __device__ __forceinline__ void operator()(const f32x4 (&acc)[2][2][4][2], const pg8::Unit& u, int wr, int wc, int fr, int fq) const {
        const int row0 = u.pm * 256 + wr * 64 + fr, col0 = u.pn * 256 + wc * 32 + 8 * fq;
        const bool ln = stats_prev != nullptr;
        typedef long long i64x2 __attribute__((ext_vector_type(2)));
        const float* __restrict__ srcr = src; float* __restrict__ Yr = Y; bf16_t* __restrict__ YBr = YB; const i64* __restrict__ spr = stats_prev;
        f32x4 gv[2][2], bv[2][2];
#pragma unroll
        for (int bj = 0; bj < 2; ++bj)
#pragma unroll
            for (int n = 0; n < 2; ++n) {
                gv[bj][n] = ln ? *(const f32x4*)(g + col0 + bj * 128 + 4 * n) : (f32x4){1.f, 1.f, 1.f, 1.f};
                bv[bj][n] = ln ? *(const f32x4*)(b + col0 + bj * 128 + 4 * n) : (f32x4){0.f, 0.f, 0.f, 0.f}; }
#pragma unroll
        for (int ai = 0; ai < 2; ++ai) {
            float mu_[4], rs_[4];
#pragma unroll
            for (int i = 0; i < 4; ++i) { const int row = row0 + ai * 128 + i * 16; mu_[i] = 0.f; rs_[i] = 1.f;
                if (ln) { const i64x2 sq = *(const i64x2*)(spr + row * 2);
                    mu_[i] = from_fx(sq[0], 1.f / DM); const float var = from_fx(sq[1], 1.f / DM) - mu_[i] * mu_[i]; rs_[i] = rsqrtf(var + LN_EPS); } }
#pragma unroll
            for (int m = 0; m < 4; ++m) {
                const int row = row0 + ai * 128 + m * 16;
                const float rs = rs_[m], mu = mu_[m];
                float s1 = 0.f, s2 = 0.f;
                const size_t ro = (size_t)row * DM + col0;
#pragma unroll
                for (int bj = 0; bj < 2; ++bj) {
                    const f32x4 p0 = *(const f32x4*)(srcr + ro + bj * 128), p1 = *(const f32x4*)(srcr + ro + bj * 128 + 4);
                    const f32x4 h0 = (p0 - mu) * rs * gv[bj][0] + bv[bj][0], h1 = (p1 - mu) * rs * gv[bj][1] + bv[bj][1];
                    const f32x4 y0 = ALPHA * h0 + acc[ai][bj][m][0], y1 = ALPHA * h1 + acc[ai][bj][m][1];
                    *(f32x4*)(Yr + ro + bj * 128) = y0; *(f32x4*)(Yr + ro + bj * 128 + 4) = y1;
#pragma unroll
                    for (int j = 0; j < 4; ++j) { s1 += y0[j] + y1[j]; s2 += y0[j] * y0[j] + y1[j] * y1[j]; }
                    u32x4 w; w.x = cvt_pk_bf16(y0[0], y0[1]); w.y = cvt_pk_bf16(y0[2], y0[3]); w.z = cvt_pk_bf16(y1[0], y1[1]); w.w = cvt_pk_bf16(y1[2], y1[3]);
                    *(u32x4*)(YBr + ro + bj * 128) = w; }
                s1 += __shfl_xor(s1, 16); s1 += __shfl_xor(s1, 32); s2 += __shfl_xor(s2, 16); s2 += __shfl_xor(s2, 32);
                if (fq == 0) { fx_add(stats_new + row * 2, s1); fx_add(stats_new + row * 2 + 1, s2); }
            }
        }
    }
};

__device__ __forceinline__ void prep_item(LAS unsigned char* lds, const WDesc& d, int item) {
    const int tid = ltid(), kp = tid >> 4, cc = tid & 15;
    const int nkc = d.K / d.kchunk, strip = item / nkc, kc = item % nkc;
    const int n0 = strip * 128, k0 = kc * d.kchunk, k1 = k0 + d.kchunk, N = d.N, K = d.K;
    const bool inr = (n0 + cc * 8) < N;
    const bool docs = d.csum != nullptr;
    float cs[8], bs[8];
#pragma unroll
    for (int j = 0; j < 8; ++j) { cs[j] = 0.f; bs[j] = 0.f; }
    int buf = 0;
    f32x4 na0 = {0.f, 0.f, 0.f, 0.f}, na1 = na0, nb0 = na0, nb1 = na0; float ng0 = 1.f, ng1 = 1.f, ne0 = 0.f, ne1 = 0.f;
#define PREP_LOAD(kt_) do { const int ka_ = (kt_) + 2 * kp; \
        if (inr) { const float* p0 = d.W + (size_t)ka_ * N + n0 + cc * 8; na0 = *(const f32x4*)p0; na1 = *(const f32x4*)(p0 + 4); nb0 = *(const f32x4*)(p0 + N); nb1 = *(const f32x4*)(p0 + N + 4); } \
        if (d.g) { ng0 = d.g[ka_]; ng1 = d.g[ka_ + 1]; } if (d.bvec) { ne0 = d.bvec[ka_]; ne1 = d.bvec[ka_ + 1]; } } while (0)
    PREP_LOAD(k0);
    for (int kt = k0; kt < k1; kt += 64) {
        const f32x4 a0 = na0, a1 = na1, b0 = nb0, b1 = nb1; const float g0 = ng0, g1 = ng1, e0 = ne0, e1 = ne1;
        if (kt + 64 < k1) PREP_LOAD(kt + 64);
        LAS unsigned* Tb = (LAS unsigned*)(lds + buf * 16896);
#pragma unroll
        for (int j = 0; j < 8; ++j) {
            const float x0 = j < 4 ? a0[j & 3] : a1[j & 3], x1 = j < 4 ? b0[j & 3] : b1[j & 3];
            const unsigned pk = cvt_pk_bf16(x0 * g0, x1 * g1);
            if (docs) { cs[j] += bf_lo(pk) + bf_hi(pk); bs[j] += e0 * x0 + e1 * x1; }
            Tb[(cc * 8 + j) * 33 + kp] = pk; }
        __syncthreads();
#pragma unroll
        for (int i = 0; i < 2; ++i) { const int id = tid + 512 * i, n = id >> 3, ch = id & 7;
            u32x4 v; v.x = Tb[n * 33 + ch * 4]; v.y = Tb[n * 33 + ch * 4 + 1]; v.z = Tb[n * 33 + ch * 4 + 2]; v.w = Tb[n * 33 + ch * 4 + 3];
            *(u32x4*)(d.WT + (size_t)(n0 + n) * K + kt + ch * 8) = v; }
        buf ^= 1;
    }
#undef PREP_LOAD
    if (docs) {
        LAS float* red = (LAS float*)(lds + 34816);
#pragma unroll
        for (int j = 0; j < 8; ++j) { red[kp * 128 + cc * 8 + j] = cs[j]; red[4096 + kp * 128 + cc * 8 + j] = bs[j]; }
        __syncthreads();
        if (tid < 256) { const int which = tid >> 7, n = tid & 127; float s = 0.f;
            for (int k = 0; k < 32; ++k) s += red[which * 4096 + k * 128 + n];
            (which ? d.bw : d.csum)[n0 + n] = s; }
    }
    __syncthreads();
}

__device__ __attribute__((noinline)) void rope_entry(float* rt, int i) {
          const int pos = i >> 5, fi = i & 31;
          double inv = 1.0; for (int k = 0; k < fi; ++k) inv *= 0.7498942093324559;
          const double ang = (double)pos * inv;
          const double n2 = __builtin_rint(ang * 0.15915494309189535);
          double r = ang - n2 * 6.283185307179586;
          const double kq = __builtin_rint(r * 0.6366197723675814);
          const double t = r - kq * 1.5707963267948966;
          const double t2 = t * t;
          const double s = t * (1.0 + t2 * (-1.0 / 6 + t2 * (1.0 / 120 + t2 * (-1.0 / 5040 + t2 * (1.0 / 362880 + t2 * (-1.0 / 39916800 + t2 * (1.0 / 6227020800.0)))))));
          const double c = 1.0 + t2 * (-0.5 + t2 * (1.0 / 24 + t2 * (-1.0 / 720 + t2 * (1.0 / 40320 + t2 * (-1.0 / 3628800 + t2 * (1.0 / 479001600.0))))));
          const int q = ((int)kq) & 3;
          const double sn = q == 0 ? s : (q == 1 ? c : (q == 2 ? -s : -c));
          const double cn = q == 0 ? c : (q == 1 ? -s : (q == 2 ? -c : s));
          rt[i] = (float)cn; rt[SEQ * 32 + i] = (float)sn;
}
__device__ __forceinline__ void phase_prep(LAS unsigned char* lds, const Params& p) {
    const int tid = ltid();
    const int gtid = lbid() * 512 + tid, gsz = lgdim() * 512;
    { i64* st = (i64*)(p.ws + OFF_STATS); for (int i = gtid; i < ST_TOTAL; i += gsz) st[i] = 0; }
    { float* rt = (float*)(p.ws + OFF_ROPE);
      for (int i = gtid; i < SEQ * 32; i += gsz) rope_entry(rt, i); }
    { const f32x4* x4 = (const f32x4*)p.in[0]; u32x2* yb = (u32x2*)(p.ws + OFF_YB);
      for (int i = gtid; i < T_ * DM / 4; i += gsz) { const f32x4 v = x4[i]; u32x2 o; o.x = cvt_pk_bf16(v[0], v[1]); o.y = cvt_pk_bf16(v[2], v[3]); yb[i] = o; } }
    for (int it = lbid(); it < p.total_items; it += lgdim()) {
        int di = 0;
        for (int k = 1; k < p.nwd; ++k) if (it >= p.wd[k].item0) di = k;
        prep_item(lds, p.wd[di], it - p.wd[di].item0);
    }
}

__device__ __forceinline__ int crow(int r, int hi) { return (r & 3) + 8 * (r >> 2) + 4 * hi; }
__device__ __forceinline__ float xhalf_(float v, int hi) { const auto rr = __builtin_amdgcn_permlane32_swap(__float_as_uint(v), __float_as_uint(v), false, false); return __uint_as_float(hi ? rr[0] : rr[1]); }
#define xhalf(v) xhalf_((v), hi)
#define MFMA32(a, b, c) __builtin_amdgcn_mfma_f32_32x32x16_bf16((a), (b), (c), 0, 0, 0)

#define DS_RD128(dst, addr, OFF) asm volatile("ds_read_b128 %0, %1 offset:%2" : "=v"(dst) : "v"(addr), "n"(OFF))
#define DS_RDTR(dst, addr, OFF)  asm volatile("ds_read_b64_tr_b16 %0, %1 offset:%2" : "=v"(dst) : "v"(addr), "n"(OFF))
#define LGKM_WAIT4(N, a, b, c, d) asm volatile("s_waitcnt lgkmcnt(" #N ")" : "+v"(a), "+v"(b), "+v"(c), "+v"(d))
#define LGKM_WAIT6(N, a, b, c, d, e, f) asm volatile("s_waitcnt lgkmcnt(" #N ")" : "+v"(a), "+v"(b), "+v"(c), "+v"(d), "+v"(e), "+v"(f))
#define LGKM_WAIT8(N, a, b, c, d, e, f, g, h) asm volatile("s_waitcnt lgkmcnt(" #N ")" : "+v"(a), "+v"(b), "+v"(c), "+v"(d), "+v"(e), "+v"(f), "+v"(g), "+v"(h))
#define SKEW_SLEEP 10
template <int V> struct IC { static constexpr int value = V; };
struct AttnArgs { const bf16_t* q; const bf16_t* kv; const bf16_t* kr; const float* rope; const float* bias; bf16_t* o; };

template <int MODE>
__device__ __forceinline__ void attn_phase(LAS unsigned char* lds, const AttnArgs& a) {
    constexpr int DQK = MODE == 0 ? 192 : 128, ND0 = DQK / 16, KSTR = 272, VSTR = 288, RSTR = 144;
    constexpr int KOFF = 0, VOFF = 64 * KSTR, ROFF = VOFF + 64 * VSTR, BUF = ROFF + (MODE == 0 ? 64 * RSTR : 0);
    constexpr int NI_K = 17, NI_V = 18, NI_R = MODE == 0 ? 9 : 0, NI = NI_K + NI_V + NI_R, NPW = (NI + 7) / 8;
    constexpr int LDQ = MODE == 0 ? 3072 : 6144, LDKV = MODE == 0 ? 4096 : 6144;
    constexpr float SC = MODE == 0 ? 0.07216878364870322f : 0.08838834764831845f;
    constexpr float C2 = SC * LOG2E;
    int tid = threadIdx.x; asm volatile("" : "+v"(tid));
    const int wid = __builtin_amdgcn_readfirstlane(tid >> 6), lane = tid & 63, r32 = lane & 31, hi = lane >> 5;
    const int i16 = lane & 15, q4 = i16 >> 2, p4 = i16 & 3, blk = (lane >> 4) & 1;
    LAS float* tb = (LAS float*)(lds + 2 * BUF);
    constexpr int QR_OFF = 2 * BUF + 768, NQR = ND0;
    unsigned voff[NPW];
#pragma unroll
    for (int i = 0; i < NPW; ++i) { const int j = wid + 8 * i;
        if (j < NI_K) { const int c = j * 64 + lane, row = c / 17, cc = c % 17; voff[i] = (unsigned)(row * (LDKV * 2) + (cc < 16 ? cc * 16 : 0)); }
        else if (j < NI_K + NI_V) { const int c = (j - NI_K) * 64 + lane, row = c / 18, cc = c % 18; voff[i] = (unsigned)(row * (LDKV * 2) + (cc < 16 ? cc * 16 : 0)); }
        else { const int c = (j - NI_K - NI_V) * 64 + lane, row = c / 9, cc = c % 9; voff[i] = (unsigned)(row * 128 + (cc < 8 ? cc * 16 : 0)); } }
    for (int bid_ = lbid(); bid_ < 256; bid_ += lgdim()) {
        const int it = bid_;
        const int bh = it >> 2, gp = it & 3, b = bh >> 4, h = bh & 15, tok0 = b * SEQ;
        for (int half = 0; half < 2; ++half) {
            const int g = half ? 7 - gp : gp;
            const int q0 = g * 256 + wid * 32, cw = q0 >> 6, qin = (q0 & 63) + r32;
            const char* kbase = (const char*)(MODE == 0 ? a.kv + h * 256 : a.q + 2048 + h * 128) + (size_t)tok0 * (LDKV * 2);
            const char* vbase_g = kbase + (MODE == 0 ? 256 : 4096);
            const char* rbase = (const char*)a.kr + (size_t)tok0 * 128;
#define ST_ISSUE(kc, bufi) do { _Pragma("unroll") for (int i_ = 0; i_ < NPW; ++i_) { const int j_ = wid + 8 * i_; if (j_ < NI) { \
    const char* src_; int dst_; \
    if (j_ < NI_K) { src_ = kbase + (size_t)(kc) * (64 * LDKV * 2); dst_ = KOFF + j_ * 1024; } \
    else if (j_ < NI_K + NI_V) { src_ = vbase_g + (size_t)(kc) * (64 * LDKV * 2); dst_ = VOFF + (j_ - NI_K) * 1024; } \
    else { src_ = rbase + (size_t)(kc) * (64 * 128); dst_ = ROFF + (j_ - NI_K - NI_V) * 1024; } \
    __builtin_amdgcn_global_load_lds((const unsigned*)(src_ + voff[i_]), (LAS unsigned*)(lds + (bufi) * BUF + dst_), 16, 0, 0); } } } while (0)
            const int kc_lo = MODE == 2 ? (4 * g - 8 > 0 ? 4 * g - 8 : 0) : 0, kc_hi = 4 * g + 3, nt = kc_hi - kc_lo + 1;
            ST_ISSUE((MODE == 1 ? kc_hi : kc_lo), 0);
            bf16x8 qr[ND0];
            { int ln = lane; asm volatile("" : "+v"(ln)); const int r32q = ln & 31, hiq = ln >> 5;
              const bf16_t* qp = a.q + (size_t)(tok0 + q0 + r32q) * LDQ + (MODE == 0 ? h * 192 : h * 128) + hiq * 8;
#pragma unroll
              for (int d0 = 0; d0 < ND0; ++d0) qr[d0] = *(const bf16x8*)(qp + d0 * 16);
              if (MODE == 0) {
                  const float* ct = a.rope + (size_t)(q0 + r32q) * 32 + hiq * 8; const float* st = ct + SEQ * 32;
#pragma unroll
                  for (int e = 0; e < 2; ++e) {
                      const f32x4 c0 = *(const f32x4*)(ct + e * 16), c1 = *(const f32x4*)(ct + e * 16 + 4), s0 = *(const f32x4*)(st + e * 16), s1 = *(const f32x4*)(st + e * 16 + 4);
                      const u32x4 x1 = __builtin_bit_cast(u32x4, qr[8 + e]), x2 = __builtin_bit_cast(u32x4, qr[10 + e]);
                      u32x4 o1, o2;
#pragma unroll
                      for (int w = 0; w < 4; ++w) {
                          const float ca = w < 2 ? c0[2 * w] : c1[2 * w - 4], cb = w < 2 ? c0[2 * w + 1] : c1[2 * w - 3];
                          const float sa = w < 2 ? s0[2 * w] : s1[2 * w - 4], sb = w < 2 ? s0[2 * w + 1] : s1[2 * w - 3];
                          const float a1 = bf_lo(x1[w]), b1 = bf_hi(x1[w]), a2 = bf_lo(x2[w]), b2 = bf_hi(x2[w]);
                          o1[w] = cvt_pk_bf16(a1 * ca - a2 * sa, b1 * cb - b2 * sb);
                          o2[w] = cvt_pk_bf16(a2 * ca + a1 * sa, b2 * cb + b1 * sb); }
                      qr[8 + e] = __builtin_bit_cast(bf16x8, o1); qr[10 + e] = __builtin_bit_cast(bf16x8, o2); } } }
            if (MODE == 0) {
#pragma unroll
                for (int f = 0; f < ND0 - NQR; ++f) *(LAS bf16x8*)(lds + QR_OFF + f * 8192 + tid * 16) = qr[NQR + f];
            }
            if (MODE == 2) { if (tid < 192) tb[tid] = a.bias[tid * 16 + h] * LOG2E; }
            f32x16 od[4];
#pragma unroll
            for (int d = 0; d < 4; ++d)
#pragma unroll
                for (int r = 0; r < 16; ++r) od[d][r] = 0.f;
            float m_run = -1e30f, l_run = 0.f, carry = 0.f;
            asm volatile("s_waitcnt vmcnt(0)" ::: "memory");
            __syncthreads();
            auto tile_step = [&](auto CURC, const int i) __attribute__((always_inline)) -> bool {
                constexpr int CUR = decltype(CURC)::value;
                const int kc = MODE == 1 ? kc_hi - i : kc_lo + i;
                if (i + 1 < nt) ST_ISSUE((MODE == 1 ? kc - 1 : kc + 1), (1 - CUR));
                const bool active = MODE == 2 ? (kc <= cw && kc >= cw - 8) : (kc <= cw);
                if (active) {
                    if (((wid >> 2) & 1) != 0) __builtin_amdgcn_s_sleep(SKEW_SLEEP);
                    LAS unsigned char* Kb = lds + CUR * BUF;
                    f32x16 p0, p1;
#pragma unroll
                    for (int r = 0; r < 16; ++r) { p0[r] = 0.f; p1[r] = 0.f; }
                    {
                        const unsigned ka = (unsigned)(size_t)(Kb + KOFF + r32 * KSTR + hi * 16), ra = (unsigned)(size_t)(Kb + ROFF + r32 * RSTR + hi * 16);
                        const unsigned pa = (unsigned)(size_t)(lds + QR_OFF + tid * 16);
                        bf16x8 kA0, kA1, kA2, kA3, kB0, kB1, kB2, kB3, qA0, qA1, qB0, qB1;
#define QK_LD(k0_, k1_, k2_, k3_, q0_, q1_, PJ) do { \
    if ((PJ) < 4) { DS_RD128(k0_, ka, (2 * (PJ)) * 32); DS_RD128(k1_, ka, (2 * (PJ)) * 32 + 32 * KSTR); DS_RD128(k2_, ka, (2 * (PJ) + 1) * 32); DS_RD128(k3_, ka, (2 * (PJ) + 1) * 32 + 32 * KSTR); } \
    else { DS_RD128(k0_, ra, (2 * ((PJ) & 3)) * 32); DS_RD128(k1_, ra, (2 * ((PJ) & 3)) * 32 + 32 * RSTR); DS_RD128(k2_, ra, (2 * ((PJ) & 3) + 1) * 32); DS_RD128(k3_, ra, (2 * ((PJ) & 3) + 1) * 32 + 32 * RSTR); \
           } } while (0)
#define QK_MM(k0_, k1_, k2_, k3_, q0_, q1_, PJ) do { \
    const bf16x8 qa_ = qr[(2 * (PJ)) < ND0 ? 2 * (PJ) : 0], qb_ = qr[(2 * (PJ) + 1) < ND0 ? 2 * (PJ) + 1 : 0]; \
    p0 = MFMA32(k0_, qa_, p0); p1 = MFMA32(k1_, qa_, p1); p0 = MFMA32(k2_, qb_, p0); p1 = MFMA32(k3_, qb_, p1); } while (0)
                        QK_LD(kA0, kA1, kA2, kA3, qA0, qA1, 0);
                        QK_LD(kB0, kB1, kB2, kB3, qB0, qB1, 1);
                        LGKM_WAIT4(4, kA0, kA1, kA2, kA3); __builtin_amdgcn_sched_barrier(0);
                        QK_MM(kA0, kA1, kA2, kA3, qA0, qA1, 0); __builtin_amdgcn_sched_barrier(0);
                        QK_LD(kA0, kA1, kA2, kA3, qA0, qA1, 2);
                        LGKM_WAIT4(4, kB0, kB1, kB2, kB3); __builtin_amdgcn_sched_barrier(0);
                        QK_MM(kB0, kB1, kB2, kB3, qB0, qB1, 1); __builtin_amdgcn_sched_barrier(0);
                        QK_LD(kB0, kB1, kB2, kB3, qB0, qB1, 3);
                        LGKM_WAIT4(4, kA0, kA1, kA2, kA3); __builtin_amdgcn_sched_barrier(0);
                        QK_MM(kA0, kA1, kA2, kA3, qA0, qA1, 2); __builtin_amdgcn_sched_barrier(0);
                        if (MODE == 0) {
                            QK_LD(kA0, kA1, kA2, kA3, qA0, qA1, 4);
                            LGKM_WAIT4(4, kB0, kB1, kB2, kB3); __builtin_amdgcn_sched_barrier(0);
                            QK_MM(kB0, kB1, kB2, kB3, qB0, qB1, 3); __builtin_amdgcn_sched_barrier(0);
                            QK_LD(kB0, kB1, kB2, kB3, qB0, qB1, 5);
                            LGKM_WAIT4(4, kA0, kA1, kA2, kA3); __builtin_amdgcn_sched_barrier(0);
                            QK_MM(kA0, kA1, kA2, kA3, qA0, qA1, 4); __builtin_amdgcn_sched_barrier(0);
                            LGKM_WAIT4(0, kB0, kB1, kB2, kB3); __builtin_amdgcn_sched_barrier(0);
                            QK_MM(kB0, kB1, kB2, kB3, qB0, qB1, 5); __builtin_amdgcn_sched_barrier(0);
                        } else {
                            LGKM_WAIT4(0, kB0, kB1, kB2, kB3); __builtin_amdgcn_sched_barrier(0);
                            QK_MM(kB0, kB1, kB2, kB3, qB0, qB1, 3); __builtin_amdgcn_sched_barrier(0);
                        }
#undef QK_LD
#undef QK_MM
                    }
                    if (MODE == 1) {
                        const bool diag = kc == cw;
#pragma unroll
                        for (int sub = 1; sub >= 0; --sub) {
                            f32x16& p = sub ? p1 : p0;
                            float l1[16], G[4], PG[4];
#pragma unroll
                            for (int r = 0; r < 16; ++r) {
                                const float z = p[r] * C2, e = __builtin_amdgcn_exp2f(-fabsf(z)), L = __builtin_amdgcn_logf(1.f + e);
                                float lb = fminf(z, 0.f) - L, lm = fminf(-z, 0.f) - L;
                                if (diag) { const bool valid = (sub * 32 + crow(r, hi)) < qin; lb = valid ? lb : -1e30f; lm = valid ? lm : 0.f; }
                                p[r] = lb; l1[r] = lm; }
#pragma unroll
                            for (int gi = 0; gi < 4; ++gi) { G[gi] = (l1[4 * gi] + l1[4 * gi + 1]) + (l1[4 * gi + 2] + l1[4 * gi + 3]); PG[gi] = xhalf(G[gi]); }
                            float run = carry;
#pragma unroll
                            for (int gi = 3; gi >= 0; --gi) {
                                const float s3 = hi ? run : run + PG[gi];
                                const float s2 = s3 + l1[4 * gi + 3], s1 = s2 + l1[4 * gi + 2], s0 = s1 + l1[4 * gi + 1];
                                p[4 * gi + 3] = __builtin_amdgcn_exp2f(p[4 * gi + 3] + s3); p[4 * gi + 2] = __builtin_amdgcn_exp2f(p[4 * gi + 2] + s2);
                                p[4 * gi + 1] = __builtin_amdgcn_exp2f(p[4 * gi + 1] + s1); p[4 * gi] = __builtin_amdgcn_exp2f(p[4 * gi] + s0);
                                run += G[gi] + PG[gi]; }
                            carry = run; }
                    } else {
                        if (MODE == 2) {
                            if (kc >= cw - 2) {
                                const int rel0 = kc * 64 - (q0 + r32);
#pragma unroll
                                for (int r = 0; r < 16; ++r) {
                                    int i0 = rel0 + crow(r, hi), i1 = i0 + 32;
                                    i0 = (i0 < -128 ? -128 : (i0 > 63 ? 63 : i0)) + 128; i1 = (i1 < -128 ? -128 : (i1 > 63 ? 63 : i1)) + 128;
                                    p0[r] = p0[r] * C2 + tb[i0]; p1[r] = p1[r] * C2 + tb[i1]; }
                            } else { const float b0 = tb[0];
#pragma unroll
                                for (int r = 0; r < 16; ++r) { p0[r] = p0[r] * C2 + b0; p1[r] = p1[r] * C2 + b0; } }
                        } else {
#pragma unroll
                            for (int r = 0; r < 16; ++r) { p0[r] *= C2; p1[r] *= C2; }
                        }
                        float mx = p0[0];
#pragma unroll
                        for (int r = 1; r < 16; ++r) mx = fmaxf(mx, p0[r]);
#pragma unroll
                        for (int r = 0; r < 16; ++r) mx = fmaxf(mx, p1[r]);
                        mx = fmaxf(mx, xhalf(mx));
                        const float mn = fmaxf(m_run, mx), al = __builtin_amdgcn_exp2f(m_run - mn);
                        m_run = mn;
                        float ps = 0.f;
#pragma unroll
                        for (int r = 0; r < 16; ++r) { p0[r] = __builtin_amdgcn_exp2f(p0[r] - mn); p1[r] = __builtin_amdgcn_exp2f(p1[r] - mn); ps += p0[r] + p1[r]; }
                        ps += xhalf(ps);
                        l_run = l_run * al + ps;
                        if (__any(al != 1.f)) {
#pragma unroll
                            for (int d = 0; d < 4; ++d)
#pragma unroll
                                for (int r = 0; r < 16; ++r) od[d][r] *= al; }
                    }
                    bf16x8 pb[4];
#pragma unroll
                    for (int s = 0; s < 4; ++s) { const f32x16& p = s < 2 ? p0 : p1; const int o = (s & 1) * 8;
                        u32x4 w; w.x = cvt_pk_bf16(p[o], p[o + 1]); w.y = cvt_pk_bf16(p[o + 2], p[o + 3]); w.z = cvt_pk_bf16(p[o + 4], p[o + 5]); w.w = cvt_pk_bf16(p[o + 6], p[o + 7]);
                        pb[s] = __builtin_bit_cast(bf16x8, w); }
                    LAS unsigned char* vbase = Kb + VOFF + (4 * hi + q4) * VSTR + blk * 32 + p4 * 8;
                    {
                        const unsigned va = (unsigned)(size_t)vbase;
                        s16x4 lA0, lA1, lA2, lA3, hA0, hA1, hA2, hA3, lB0, lB1, lB2, lB3, hB0, hB1, hB2, hB3;
#define PV_LD(l0, l1, l2, l3, h0, h1, h2, h3, D_) do { \
    DS_RDTR(l0, va, 0 * 16 * VSTR + (D_) * 64); DS_RDTR(h0, va, (0 * 16 + 8) * VSTR + (D_) * 64); DS_RDTR(l1, va, 1 * 16 * VSTR + (D_) * 64); DS_RDTR(h1, va, (1 * 16 + 8) * VSTR + (D_) * 64); \
    DS_RDTR(l2, va, 2 * 16 * VSTR + (D_) * 64); DS_RDTR(h2, va, (2 * 16 + 8) * VSTR + (D_) * 64); DS_RDTR(l3, va, 3 * 16 * VSTR + (D_) * 64); DS_RDTR(h3, va, (3 * 16 + 8) * VSTR + (D_) * 64); } while (0)
#define PV_MM(l0, l1, l2, l3, h0, h1, h2, h3, D_) do { \
    od[D_] = MFMA32(__builtin_shufflevector(l0, h0, 0, 1, 2, 3, 4, 5, 6, 7), pb[0], od[D_]); od[D_] = MFMA32(__builtin_shufflevector(l1, h1, 0, 1, 2, 3, 4, 5, 6, 7), pb[1], od[D_]); \
    od[D_] = MFMA32(__builtin_shufflevector(l2, h2, 0, 1, 2, 3, 4, 5, 6, 7), pb[2], od[D_]); od[D_] = MFMA32(__builtin_shufflevector(l3, h3, 0, 1, 2, 3, 4, 5, 6, 7), pb[3], od[D_]); } while (0)
                        PV_LD(lA0, lA1, lA2, lA3, hA0, hA1, hA2, hA3, 0);
                        PV_LD(lB0, lB1, lB2, lB3, hB0, hB1, hB2, hB3, 1);
                        LGKM_WAIT8(8, lA0, lA1, lA2, lA3, hA0, hA1, hA2, hA3); __builtin_amdgcn_sched_barrier(0);
                        PV_MM(lA0, lA1, lA2, lA3, hA0, hA1, hA2, hA3, 0); __builtin_amdgcn_sched_barrier(0);
                        PV_LD(lA0, lA1, lA2, lA3, hA0, hA1, hA2, hA3, 2);
                        LGKM_WAIT8(8, lB0, lB1, lB2, lB3, hB0, hB1, hB2, hB3); __builtin_amdgcn_sched_barrier(0);
                        PV_MM(lB0, lB1, lB2, lB3, hB0, hB1, hB2, hB3, 1); __builtin_amdgcn_sched_barrier(0);
                        PV_LD(lB0, lB1, lB2, lB3, hB0, hB1, hB2, hB3, 3);
                        LGKM_WAIT8(8, lA0, lA1, lA2, lA3, hA0, hA1, hA2, hA3); __builtin_amdgcn_sched_barrier(0);
                        PV_MM(lA0, lA1, lA2, lA3, hA0, hA1, hA2, hA3, 2); __builtin_amdgcn_sched_barrier(0);
                        LGKM_WAIT8(0, lB0, lB1, lB2, lB3, hB0, hB1, hB2, hB3); __builtin_amdgcn_sched_barrier(0);
                        PV_MM(lB0, lB1, lB2, lB3, hB0, hB1, hB2, hB3, 3); __builtin_amdgcn_sched_barrier(0);
#undef PV_LD
#undef PV_MM
                    }
                }
                asm volatile("s_waitcnt vmcnt(0)" ::: "memory");
                if (MODE == 1) {
                    if (__syncthreads_and((kc <= cw) && (carry <= -160.f))) return true;
                } else __syncthreads();
                return false;
            };
            for (int i = 0; i < nt; i += 2) {
                if (tile_step(IC<0>{}, i)) break;
                if (i + 1 < nt) { if (tile_step(IC<1>{}, i + 1)) break; }
            }
#undef ST_ISSUE
            const float inv = MODE == 1 ? 1.f : 1.f / l_run;
            int lo_ = lane; asm volatile("" : "+v"(lo_));
            bf16_t* op = a.o + (size_t)(tok0 + q0 + (lo_ & 31)) * DM + h * 128 + 4 * (lo_ >> 5);
#pragma unroll
            for (int d = 0; d < 4; ++d)
#pragma unroll
                for (int gq = 0; gq < 4; ++gq) {
                    u32x2 w; w.x = cvt_pk_bf16(od[d][4 * gq] * inv, od[d][4 * gq + 1] * inv); w.y = cvt_pk_bf16(od[d][4 * gq + 2] * inv, od[d][4 * gq + 3] * inv);
                    *(u32x2*)(op + d * 32 + 8 * gq) = w; }
            if (MODE == 1) __syncthreads();
        }
    }
}

__device__ __forceinline__ void krope_phase(const bf16_t* down, const float* rope, bf16_t* kr) {
    const size_t gtid = (size_t)lbid() * 512 + ltid(), gsz = (size_t)lgdim() * 512;
    for (size_t i = gtid; i < (size_t)T_ * 32; i += gsz) {
        const int t = (int)(i >> 5), fi = (int)(i & 31), pos = t & (SEQ - 1);
        const float c = rope[pos * 32 + fi], s = rope[SEQ * 32 + pos * 32 + fi];
        const float x1 = __uint_as_float((unsigned)down[(size_t)t * 1280 + 1024 + fi] << 16), x2 = __uint_as_float((unsigned)down[(size_t)t * 1280 + 1056 + fi] << 16);
        const unsigned o = cvt_pk_bf16(x1 * c - x2 * s, x2 * c + x1 * s);
        kr[(size_t)t * 64 + fi] = (bf16_t)(o & 0xffff); kr[(size_t)t * 64 + 32 + fi] = (bf16_t)(o >> 16); }
}

__device__ __forceinline__ void final_ln(const float* Y, const i64* stats, const float* g, const float* b, float* out) {
    const size_t gtid = (size_t)lbid() * 512 + ltid(), gsz = (size_t)lgdim() * 512;
    for (size_t i = gtid; i < (size_t)T_ * DM / 4; i += gsz) {
        const int row = (int)(i >> 9), c4 = (int)(i & 511);
        const float mu = from_fx(stats[row * 2], 1.f / DM), var = from_fx(stats[row * 2 + 1], 1.f / DM) - mu * mu, rs = rsqrtf(var + LN_EPS);
        const f32x4 v = ((const f32x4*)Y)[i], gg = ((const f32x4*)g)[c4], bb = ((const f32x4*)b)[c4];
        ((f32x4*)out)[i] = (v - mu) * rs * gg + bb; }
}


#define XB_TMO      128
#define XB_XCNT(j)  (256  + 64 * (j))
#define XB_XSUB(j)  (1280 + 64 * (j))
#define XB_XGEN(j)  (2304 + 64 * (j))
#define XB_TOP      3328
#define XB_TOPGEN   3392
#define XCD_BAR_WORDS 3456
#define XB_SPIN_CAP (1u << 18)
__device__ __forceinline__ unsigned xb_ld(unsigned* p)              { return __hip_atomic_load(p, __ATOMIC_RELAXED, __HIP_MEMORY_SCOPE_AGENT); }
__device__ __forceinline__ unsigned xb_add(unsigned* p, unsigned v) { return __hip_atomic_fetch_add(p, v, __ATOMIC_RELAXED, __HIP_MEMORY_SCOPE_AGENT); }
__device__ __forceinline__ unsigned xb_xcc_id() { return (unsigned)__builtin_amdgcn_s_getreg((3 << 11) | 20) & 0xFu; }
#define XB_SPIN(cond, bar) do { unsigned _sp = 0; while (cond) { __builtin_amdgcn_s_sleep(1); \
    if ((++_sp & 255u) == 0u) { if (xb_ld(&(bar)[XB_TMO])) break; if (_sp > XB_SPIN_CAP) { atomicAdd(&(bar)[XB_TMO], 1u); break; } } } } while (0)
__device__ __forceinline__ void xcd_barrier_complete(unsigned* bar, unsigned x, unsigned& nloc, unsigned& nx) {
    const unsigned G = gridDim.x;
    unsigned sum, cnt, mine, sp = 0u;
    for (;;) {
        sum = 0u; cnt = 0u; mine = 0u;
#pragma unroll
        for (unsigned j = 0; j < 16; ++j) { const unsigned c = xb_ld(&bar[XB_XCNT(j)]); sum += c; cnt += (c > 0u) ? 1u : 0u; mine = (j == x) ? c : mine; }
        if (sum == G) break;
        __builtin_amdgcn_s_sleep(1);
        if ((++sp & 255u) == 0u) { if (xb_ld(&bar[XB_TMO])) break; if (sp > XB_SPIN_CAP) { atomicAdd(&bar[XB_TMO], 1u); break; } }
    }
    nloc = mine > 0u ? mine : 1u; nx = cnt > 0u ? cnt : 1u;
}
__device__ __forceinline__ void xcd_barrier(unsigned* bar, volatile LAS unsigned* st) {
    asm volatile("s_waitcnt vmcnt(0)" ::: "memory");
    __syncthreads();
    if (threadIdx.x == 0) {
        const unsigned x = xb_xcc_id();
        __builtin_amdgcn_s_waitcnt(0);
        unsigned nloc = st[0], nx = st[1];
        if (nloc == 0u) { xcd_barrier_complete(bar, x, nloc, nx); st[0] = nloc; st[1] = nx; }
        const unsigned old = xb_add(&bar[XB_XSUB(x)], 1u);
        const unsigned gen = old / nloc;
        if (old + 1u == (gen + 1u) * nloc) {
            __builtin_amdgcn_fence(__ATOMIC_RELEASE, "agent");
            asm volatile("s_waitcnt vmcnt(0)" ::: "memory");
            const unsigned og = xb_add(&bar[XB_TOP], 1u);
            const unsigned tg = og / nx;
            if (og + 1u == (tg + 1u) * nx) xb_add(&bar[XB_TOPGEN], 1u);
            else XB_SPIN(xb_ld(&bar[XB_TOPGEN]) == tg, bar);
            __builtin_amdgcn_fence(__ATOMIC_ACQUIRE, "agent");
            xb_add(&bar[XB_XGEN(x)], 1u);
            asm volatile("s_waitcnt vmcnt(0)" ::: "memory");
        } else {
            XB_SPIN(xb_ld(&bar[XB_XGEN(x)]) == gen, bar);
            __builtin_amdgcn_fence(__ATOMIC_ACQUIRE, "agent");
            asm volatile("s_waitcnt vmcnt(0)" ::: "memory");
        }
    }
    __syncthreads();
}
__device__ __forceinline__ void run_phase(LAS unsigned char* lds, const Params& p, int code) {
    size_t zoff = 0; asm volatile("" : "+s"(zoff));
    unsigned char* ws = p.ws + zoff;
    const int layer = code >> 4, step = code & 15;
    const int kind = layer % 3, slot = layer / 3, sl_mix = 2 * layer, sl_ffn = 2 * layer + 1;
    float* vec = (float*)(ws + OFF_VEC);
    i64* stats = (i64*)(ws + OFF_STATS);
    const float* rope = (const float*)(ws + OFF_ROPE);
    float* Y = (float*)(ws + OFF_Y);
    bf16_t* YB = (bf16_t*)(ws + OFF_YB);
    bf16_t* QKV = (bf16_t*)(ws + OFF_QKV);
    bf16_t* OB = (bf16_t*)(ws + OFF_O);
    bf16_t* HID = (bf16_t*)(ws + OFF_HID);
    const i64* st_in = layer == 0 ? nullptr : stats + (size_t)(sl_mix - 1) * T_ * 2;
    const unsigned char* wm = ws + OFF_MLA + slot * MLA_SLOT;
    bf16_t* DOWN = (bf16_t*)((unsigned char*)QKV + QKV_DOWN); bf16_t* Qb = (bf16_t*)((unsigned char*)QKV + QKV_Q);
    bf16_t* KVb = (bf16_t*)((unsigned char*)QKV + QKV_KV); bf16_t* KRb = (bf16_t*)((unsigned char*)QKV + QKV_KR);
    i64* rowss = stats + ST_ROWSS + (size_t)slot * T_ * 2;
    pg8::StaticOrder S;
    switch (step) {
    case 0: phase_prep(lds, p); break;
    case 1: { pg8::Gemm g{YB, (const bf16_t*)(wm + MLA_DOWN), T_, 1280, DM, DM}; S.init(T_, 1280, lgdim(), lbid());
              EpiProj<0, 0> E{DOWN, 1280, st_in, 0, vec + V_MD_CS + slot * 1280, vec + V_MD_BW + slot * 1280, rowss};
              pg8::gemm_phase(lds, g, S, E); } break;
    case 2: { krope_phase(DOWN, rope, KRb);
              { pg8::Gemm g{DOWN, (const bf16_t*)(wm + MLA_UQ), T_, 3072, 512, 1280}; S.init(T_, 3072, lgdim(), lbid());
                EpiProj<2, 0> E{Qb, 3072, rowss, 0, nullptr, nullptr, nullptr};
                pg8::gemm_phase(lds, g, S, E); }
              { pg8::Gemm g{DOWN + 512, (const bf16_t*)(wm + MLA_UKV), T_, 4096, 512, 1280}; S.init(T_, 4096, lgdim(), lbid());
                EpiProj<2, 0> E{KVb, 4096, rowss, 1, nullptr, nullptr, nullptr};
                pg8::gemm_phase(lds, g, S, E); } } break;
    case 3: { AttnArgs a{Qb, KVb, KRb, rope, nullptr, OB}; attn_phase<0>(lds, a); } break;
    case 4: { const unsigned char* wq = ws + (kind == 1 ? OFF_SB : OFF_CA);
              pg8::Gemm g{YB, (const bf16_t*)wq, T_, 6144, DM, DM}; S.init(T_, 6144, lgdim(), lbid());
              EpiProj<0, 0> E{QKV, 6144, st_in, 0, vec + (kind == 1 ? V_SB_CS : V_CA_CS), vec + (kind == 1 ? V_SB_BW : V_CA_BW), nullptr};
              pg8::gemm_phase(lds, g, S, E); } break;
    case 5: { AttnArgs a{QKV, nullptr, nullptr, nullptr, nullptr, OB}; attn_phase<1>(lds, a); } break;
    case 6: { AttnArgs a{QKV, nullptr, nullptr, nullptr, p.in[16], OB}; attn_phase<2>(lds, a); } break;
    case 7: { const bf16_t* wo = (const bf16_t*)(kind == 0 ? ws + OFF_MLA + slot * MLA_SLOT + MLA_WO : (kind == 1 ? ws + OFF_SB + 24 * MB : ws + OFF_CA + 24 * MB));
              pg8::Gemm g{OB, wo, T_, DM, DM, DM}; S.init(T_, DM, lgdim(), lbid());
              const float* lg = layer == 0 ? nullptr : p.in[3] + (size_t)(layer - 1) * DM; const float* lb = layer == 0 ? nullptr : p.in[4] + (size_t)(layer - 1) * DM;
              EpiRes E{layer == 0 ? p.in[0] : Y, Y, YB, st_in, lg, lb, stats + (size_t)sl_mix * T_ * 2};
              pg8::gemm_phase(lds, g, S, E); } break;
    case 8: { pg8::Gemm g{YB, (const bf16_t*)(ws + OFF_WFI + (size_t)layer * 32 * MB), T_, DFF, DM, DM}; S.init(T_, DFF, lgdim(), lbid());
              EpiProj<0, 1> E{HID, DFF, stats + (size_t)sl_mix * T_ * 2, 0, vec + V_FI_CS + layer * 8192, vec + V_FI_BW + layer * 8192, nullptr};
              pg8::gemm_phase(lds, g, S, E); } break;
    case 9: { pg8::Gemm g{HID, (const bf16_t*)(ws + OFF_WFO + (size_t)layer * 32 * MB), T_, DM, DFF, DFF}; S.init(T_, DM, lgdim(), lbid());
              EpiRes E{Y, Y, YB, stats + (size_t)sl_mix * T_ * 2, p.in[1] + (size_t)layer * DM, p.in[2] + (size_t)layer * DM, stats + (size_t)sl_ffn * T_ * 2};
              pg8::gemm_phase(lds, g, S, E); } break;
    default: final_ln(Y, stats + (size_t)7 * T_ * 2, p.in[3] + 3 * DM, p.in[4] + 3 * DM, p.out); break;
    }
}

__global__ void __launch_bounds__(512, 2) fwd_megakernel(Params p) {
    extern __shared__ __attribute__((aligned(16))) unsigned char shm[];
    LAS unsigned char* lds = (LAS unsigned char*)shm;
    __builtin_assume(__builtin_amdgcn_workitem_id_y() == 0); __builtin_assume(__builtin_amdgcn_workitem_id_z() == 0);
    cg::grid_group grid = cg::this_grid();
    volatile LAS unsigned* st = (volatile LAS unsigned*)(lds + XB_ST_OFF);
    unsigned* bar = (unsigned*)(p.ws + OFF_BAR);
    if (threadIdx.x == 0) { st[0] = 0u; st[1] = 0u; (void)xb_add(&bar[XB_XCNT(xb_xcc_id())], 1u); }
    __syncthreads();
    for (int ph = p.ph_lo; ph < p.ph_hi; ++ph) {
        const int code = p.prog[ph];
        run_phase(lds, p, code);
        if (ph + 1 < p.ph_hi) {
            if (p.ph_hi > 48) grid.sync(); else xcd_barrier((unsigned*)(p.ws + OFF_BAR), st); }
    }
}

constexpr int LDS_BYTES = 155648;

extern "C" void kernel_launch(void* const* d_in, const int* in_sizes, int n_in, void* d_out, int out_size, void* d_ws, size_t ws_size, hipStream_t stream) {
    static int grid_blocks = 0;
    if (!grid_blocks) {
        int dev = 0, cus = 0, per_cu = 0;
        hipGetDevice(&dev);
        hipDeviceGetAttribute(&cus, hipDeviceAttributeMultiprocessorCount, dev);
        hipFuncSetAttribute((const void*)fwd_megakernel, hipFuncAttributeMaxDynamicSharedMemorySize, LDS_BYTES);
        hipOccupancyMaxActiveBlocksPerMultiprocessor(&per_cu, (const void*)fwd_megakernel, 512, LDS_BYTES);
        if (per_cu < 1) per_cu = 1;
        grid_blocks = cus * per_cu;
        if (ws_size < WS_END) fprintf(stderr, "workspace too small: %zu < %zu\n", ws_size, (size_t)WS_END);
    }
    Params p{};
    for (int i = 0; i < 18; ++i) p.in[i] = (const float*)d_in[i];
    p.out = (float*)d_out; p.ws = (unsigned char*)d_ws;
    unsigned char* ws = (unsigned char*)d_ws; float* vec = (float*)(ws + OFF_VEC);
    int n = 0, items = 0;
    auto add = [&](const float* W, void* WT, const float* g, const float* bvec, float* csum, float* bw, int K, int N, int Npad, int kchunk) {
        WDesc& d = p.wd[n++]; d.W = W; d.WT = (bf16_t*)WT; d.g = g; d.bvec = bvec; d.csum = csum; d.bw = bw; d.K = K; d.N = N; d.Npad = Npad; d.kchunk = kchunk;
        d.item0 = items; d.nitems = (Npad / 128) * (K / kchunk); items += d.nitems; };
    for (int l = 0; l < 4; ++l) add(p.in[5] + (size_t)l * DM * DFF, ws + OFF_WFI + (size_t)l * 32 * MB, p.in[1] + l * DM, p.in[2] + l * DM, vec + V_FI_CS + l * 8192, vec + V_FI_BW + l * 8192, DM, DFF, DFF, DM);
    for (int l = 0; l < 4; ++l) add(p.in[6] + (size_t)l * DM * DFF, ws + OFF_WFO + (size_t)l * 32 * MB, nullptr, nullptr, nullptr, nullptr, DFF, DM, DM, 2048);
    add(p.in[13], ws + OFF_SB, p.in[3] + 0 * DM, p.in[4] + 0 * DM, vec + V_SB_CS, vec + V_SB_BW, DM, 6144, 6144, DM);
    add(p.in[15], ws + OFF_CA, p.in[3] + 1 * DM, p.in[4] + 1 * DM, vec + V_CA_CS, vec + V_CA_BW, DM, 6144, 6144, DM);
    add(p.in[14], ws + OFF_SB + 24 * MB, nullptr, nullptr, nullptr, nullptr, DM, DM, DM, DM);
    add(p.in[17], ws + OFF_CA + 24 * MB, nullptr, nullptr, nullptr, nullptr, DM, DM, DM, DM);
    for (int s = 0; s < 2; ++s) add(p.in[12] + (size_t)s * DM * DM, ws + OFF_MLA + s * MLA_SLOT + MLA_WO, nullptr, nullptr, nullptr, nullptr, DM, DM, DM, DM);
    add(p.in[7], ws + OFF_MLA + MLA_DOWN, nullptr, nullptr, nullptr, nullptr, DM, 1088, 1280, DM);
    add(p.in[7] + (size_t)DM * 1088, ws + OFF_MLA + MLA_SLOT + MLA_DOWN, p.in[3] + 2 * DM, p.in[4] + 2 * DM, vec + V_MD_CS + 1280, vec + V_MD_BW + 1280, DM, 1088, 1280, DM);
    for (int s = 0; s < 2; ++s) add(p.in[9] + (size_t)s * 512 * 3072, ws + OFF_MLA + s * MLA_SLOT + MLA_UQ, p.in[8] + s * 512, nullptr, nullptr, nullptr, 512, 3072, 3072, 512);
    for (int s = 0; s < 2; ++s) add(p.in[11] + (size_t)s * 512 * 4096, ws + OFF_MLA + s * MLA_SLOT + MLA_UKV, p.in[10] + s * 512, nullptr, nullptr, nullptr, 512, 4096, 4096, 512);
    p.nwd = n; p.total_items = items;
    int np = 0;
    p.prog[np++] = 0;
    for (int l = 0; l < 4; ++l) {
        const int kind = l % 3;
        if (kind == 0) { p.prog[np++] = (l << 4) | 1; p.prog[np++] = (l << 4) | 2; p.prog[np++] = (l << 4) | 3; }
        else { p.prog[np++] = (l << 4) | 4; p.prog[np++] = (l << 4) | (kind == 1 ? 5 : 6); }
        p.prog[np++] = (l << 4) | 7; p.prog[np++] = (l << 4) | 8; p.prog[np++] = (l << 4) | 9;
    }
    p.prog[np++] = 10;
    p.ph_lo = 0; p.ph_hi = np;
    hipMemsetAsync((unsigned char*)d_ws + OFF_BAR, 0, 3456 * 4, stream);
    void* args[] = {&p};
    hipError_t e = hipLaunchCooperativeKernel((const void*)fwd_megakernel, dim3(grid_blocks), dim3(512), args, LDS_BYTES, stream);
    if (e != hipSuccess) fprintf(stderr, "cooperative launch failed: %s (grid %d)\n", hipGetErrorString(e), grid_blocks);
}
```

```cpp
#include <hip/hip_runtime.h>
#include <hip/hip_cooperative_groups.h>
#include <cstdio>
namespace cg = cooperative_groups;

#define LAS __attribute__((address_space(3)))
typedef unsigned short bf16_t;
typedef short bf16x8 __attribute__((ext_vector_type(8)));
typedef short s16x4 __attribute__((ext_vector_type(4)));
typedef float f32x4 __attribute__((ext_vector_type(4)));
typedef float f32x16 __attribute__((ext_vector_type(16)));
typedef unsigned u32x4 __attribute__((ext_vector_type(4)));
typedef unsigned u32x2 __attribute__((ext_vector_type(2)));

constexpr int T_ = 8192, DM = 2048, DFF = 8192, SEQ = 2048;
constexpr float ALPHA = 1.6817928305074290f;
constexpr float LN_EPS = 1e-5f, RMS_EPS = 1e-6f;
constexpr float LOG2E = 1.4426950408889634f;

constexpr size_t MB = 1ull << 20;
constexpr size_t OFF_WFI = 0, OFF_WFO = 128 * MB, OFF_MLA = 256 * MB, OFF_SB = 296 * MB, OFF_CA = 328 * MB, OFF_VEC = 360 * MB,
                 OFF_STATS = 361 * MB, OFF_ROPE = 363 * MB, OFF_Y = 364 * MB, OFF_YB = 428 * MB, OFF_QKV = 460 * MB, OFF_O = 600 * MB,
                 OFF_HID = 632 * MB, WS_END = 760 * MB;
constexpr size_t OFF_BAR = OFF_STATS + 3 * MB / 2;
constexpr int XB_ST_OFF = 155648 - 16;
constexpr size_t MLA_SLOT = 20 * MB, MLA_DOWN = 0, MLA_UQ = 5 * MB, MLA_UKV = 8 * MB, MLA_WO = 12 * MB;
constexpr size_t QKV_DOWN = 0, QKV_Q = 20 * MB, QKV_KV = 68 * MB, QKV_KR = 132 * MB;
constexpr int V_FI_CS = 0, V_FI_BW = 4 * 8192, V_MD_CS = 8 * 8192, V_MD_BW = V_MD_CS + 2 * 1280, V_SB_CS = V_MD_BW + 2 * 1280, V_SB_BW = V_SB_CS + 6144,
              V_CA_CS = V_SB_BW + 6144, V_CA_BW = V_CA_CS + 6144;
constexpr int ST_ROWSS = 8 * T_ * 2, ST_TOTAL = 10 * T_ * 2;

struct WDesc { const float* W; bf16_t* WT; const float* g; const float* bvec; float* csum; float* bw; int K, N, Npad, kchunk, item0, nitems; };
struct Params {
    const float* in[18];
    float* out; unsigned char* ws;
    WDesc wd[20];
    int nwd, total_items, ph_lo, ph_hi;
    int main_items, pad_;
    unsigned char prog[48];
};

__device__ __forceinline__ unsigned cvt_pk_bf16(float lo, float hi) { unsigned r; asm volatile("v_cvt_pk_bf16_f32 %0, %1, %2" : "=v"(r) : "v"(lo), "v"(hi)); return r; }
__device__ __forceinline__ int ltid() { int t = threadIdx.x; asm volatile("" : "+v"(t)); return t; }
__device__ __forceinline__ int lgdim() { int t = gridDim.x; asm volatile("" : "+s"(t)); return t; }
__device__ __forceinline__ int lbid() { int t = blockIdx.x; asm volatile("" : "+s"(t)); return t; }
typedef long long i64;
__device__ __forceinline__ i64 to_fx(float v) { const float fl = floorf(v); const unsigned lo = (unsigned)((v - fl) * 4294967296.0f); return (i64)(((unsigned long long)(unsigned)(int)fl << 32) | lo); }
__device__ __forceinline__ float from_fx(i64 v, float scale) { const int hi = (int)(v >> 32); const unsigned lo = (unsigned)v; return ((float)hi + (float)lo * 2.3283064365386963e-10f) * scale; }
__device__ __forceinline__ void fx_add(i64* p, float v) { atomicAdd((unsigned long long*)p, (unsigned long long)to_fx(v)); }
__device__ __forceinline__ float bf_lo(unsigned u) { return __uint_as_float(u << 16); }
__device__ __forceinline__ float bf_hi(unsigned u) { return __uint_as_float(u & 0xffff0000u); }

namespace pg8 {
constexpr int BM = 256, BK = 64, HALF = 128, HTB = HALF * BK * 2, STAGE_BYTES = 8 * HTB, NXCD = 8, WGM = 8;
__host__ __device__ __forceinline__ int lds_byte(int r, int c) { const int st = (r >> 4) * 2 + (c >> 5), rr = r & 15, cc = c & 31, ob = rr * 64 + cc * 2; return st * 1024 + (ob ^ (((ob >> 9) & 1) << 5)); }
__host__ __device__ __forceinline__ void stage_rc(int b, int& R, int& C) { const int st = b / 1024, sb = b % 1024, swz = sb ^ (((sb >> 9) & 1) << 5); R = (st >> 1) * 16 + swz / 64; C = (st & 1) * 32 + (swz % 64) / 2; }
__host__ __device__ __forceinline__ int perm32(int rho) { const int n = rho >> 4, i = rho & 15; return 8 * (i >> 2) + 4 * n + (i & 3); }
struct Unit { int pm, pn; };
struct Gemm { const bf16_t* A; const bf16_t* Bt; int M, N, K, lda; };
struct StaticOrder {
    int nM, nN, nwg, G, c;
    __device__ void init(int M, int N, int G_, int c_) { nM = M / BM; nN = N / BM; nwg = nM * nN; G = G_; c = c_; }
    __device__ bool next(int i, Unit& u) const {
        const long L = (long)i * G + c; if (L >= nwg) return false;
        int wgid = (int)L; { const int q = nwg / NXCD, r = nwg % NXCD, xcd = wgid % NXCD, off = wgid / NXCD; wgid = (xcd < r ? xcd * (q + 1) : r * (q + 1) + (xcd - r) * q) + off; }
        const int nig = WGM * nN, gid = wgid / nig, fm = gid * WGM, gsz = (nM - fm) < WGM ? (nM - fm) : WGM;
        u.pm = fm + ((wgid % nig) % gsz); u.pn = (wgid % nig) / gsz; return true;
    }
};

template <class Epi>
__device__ __forceinline__ void gemm_phase(LAS unsigned char* lds, const Gemm g, const StaticOrder& S, const Epi& E) {
    int tid = threadIdx.x; asm volatile("" : "+v"(tid));
    const int wid = __builtin_amdgcn_readfirstlane(tid >> 6), lane = tid & 63, wr = wid >> 2, wc = wid & 3, fr = lane & 15, fq = lane >> 4;
    const int K = g.K, nt = K / BK, lda = g.lda;
    unsigned voffA[2], voffB[2];
#pragma unroll
    for (int i = 0; i < 2; ++i) { int R, C; stage_rc(tid * 16 + i * 8192, R, C); const int Rb = Epi::PERM ? ((R & ~31) + perm32(R & 31)) : R;
        voffA[i] = (unsigned)(R * lda + C) * 2u; voffB[i] = (unsigned)(Rb * K + C) * 2u; }
    const size_t kstep = (size_t)(BK * 2);
    const size_t hstepA = (size_t)HALF * lda * 2, hstepB = (size_t)HALF * K * 2;
    const size_t tstepA = 2 * hstepA, tstepB = 2 * hstepB;
    const unsigned ldsw = (unsigned)wid * 1024u;
    const int aoff = lds_byte(wr * 64 + fr, fq * 8), boff = lds_byte(wc * 32 + fr, fq * 8);
#define PG8_SA(b, h) (((b) * 2 + (h)) * HTB)
#define PG8_SB(b, h) ((4 + (b) * 2 + (h)) * HTB)
#define PG8_STAGE(bufoff, gbase, voff) do { _Pragma("unroll") for (int _i = 0; _i < 2; ++_i) \
        __builtin_amdgcn_global_load_lds((const unsigned*)((const char*)(gbase) + (voff)[_i]), (LAS unsigned*)(lds + (bufoff) + ldsw + _i * 8192), 16, 0, 0); } while (0)
#define PG8_LDA(dst, b, h) do { _Pragma("unroll") for (int m = 0; m < 4; ++m) _Pragma("unroll") for (int k = 0; k < 2; ++k) dst[m][k] = *(const LAS bf16x8*)(lds + PG8_SA(b, h) + aoff + m * 2048 + k * 1024); } while (0)
#define PG8_LDB(dst, b, h) do { _Pragma("unroll") for (int n = 0; n < 2; ++n) _Pragma("unroll") for (int k = 0; k < 2; ++k) dst[n][k] = *(const LAS bf16x8*)(lds + PG8_SB(b, h) + boff + n * 2048 + k * 1024); } while (0)
#define PG8_MMA(ai, bj, At, Bt) do { __builtin_amdgcn_s_setprio(1); _Pragma("unroll") for (int m = 0; m < 4; ++m) _Pragma("unroll") for (int n = 0; n < 2; ++n) _Pragma("unroll") for (int k = 0; k < 2; ++k) \
        acc[ai][bj][m][n] = __builtin_amdgcn_mfma_f32_16x16x32_bf16(Bt[n][k], At[m][k], acc[ai][bj][m][n], 0, 0, 0); __builtin_amdgcn_s_setprio(0); } while (0)
#define PG8_WAIT_V(n) asm volatile("s_waitcnt vmcnt(" #n ")" ::: "memory")
#define PG8_WAIT_L(n) asm volatile("s_waitcnt lgkmcnt(" #n ")" ::: "memory")
#define PG8_BAR __builtin_amdgcn_s_barrier()
#define PG8_SCHED __builtin_amdgcn_sched_barrier(0)
    Unit cur, nxt; int ui = 0;
    if (!S.next(0, cur)) return;
    f32x4 acc[2][2][4][2];
#pragma unroll
    for (int a = 0; a < 2; ++a)
#pragma unroll
        for (int b = 0; b < 2; ++b)
#pragma unroll
            for (int m = 0; m < 4; ++m)
#pragma unroll
                for (int n = 0; n < 2; ++n) acc[a][b][m][n] = (f32x4){0.f, 0.f, 0.f, 0.f};
    bf16x8 At[4][2], B0[2][2], B1[2][2];
    const char* cA = (const char*)g.A + (size_t)cur.pm * tstepA; const char* cB = (const char*)g.Bt + (size_t)cur.pn * tstepB;
    PG8_STAGE(PG8_SB(0, 0), cB, voffB); PG8_STAGE(PG8_SA(0, 0), cA, voffA); PG8_STAGE(PG8_SB(0, 1), cB + hstepB, voffB); PG8_STAGE(PG8_SA(0, 1), cA + hstepA, voffA);
    if (wr == 1) PG8_BAR;
    PG8_WAIT_V(4); PG8_BAR;
    PG8_STAGE(PG8_SB(1, 0), cB + kstep, voffB); PG8_STAGE(PG8_SA(1, 0), cA + kstep, voffA); PG8_STAGE(PG8_SB(1, 1), cB + hstepB + kstep, voffB);
    PG8_WAIT_V(6); PG8_BAR;
    for (;;) {
        const bool has_next = S.next(ui + 1, nxt);
        const char* nA = has_next ? (const char*)g.A + (size_t)nxt.pm * tstepA : cA; const char* nB = has_next ? (const char*)g.Bt + (size_t)nxt.pn * tstepB : cB;
        for (int t = 0; t < nt; t += 2) {
            const bool last = (t == nt - 2);
            const char* a1 = cA + (size_t)(t + 1) * kstep;
            const char* a2 = last ? nA : cA + (size_t)(t + 2) * kstep; const char* b2 = last ? nB : cB + (size_t)(t + 2) * kstep;
            const char* a3 = a2 + kstep; const char* b3 = b2 + kstep;
            PG8_LDB(B0, 0, 0); PG8_SCHED; PG8_LDA(At, 0, 0); PG8_STAGE(PG8_SA(1, 1), a1 + hstepA, voffA);
            PG8_WAIT_L(8); PG8_BAR; PG8_WAIT_L(0); PG8_MMA(0, 0, At, B0); PG8_BAR; PG8_SCHED;
            PG8_LDB(B1, 0, 1); PG8_STAGE(PG8_SB(0, 0), b2, voffB);
            PG8_BAR; PG8_WAIT_L(0); PG8_MMA(0, 1, At, B1); PG8_BAR;
            PG8_LDA(At, 0, 1); PG8_STAGE(PG8_SA(0, 0), a2, voffA);
            PG8_BAR; PG8_WAIT_L(0); PG8_MMA(1, 0, At, B0); PG8_BAR; PG8_SCHED;
            PG8_STAGE(PG8_SB(0, 1), b2 + hstepB, voffB);
            PG8_WAIT_V(6); PG8_BAR; PG8_MMA(1, 1, At, B1); PG8_BAR;
            PG8_LDB(B0, 1, 0); PG8_SCHED; PG8_LDA(At, 1, 0); PG8_STAGE(PG8_SA(0, 1), a2 + hstepA, voffA);
            PG8_WAIT_L(8); PG8_BAR; PG8_WAIT_L(0); PG8_MMA(0, 0, At, B0); PG8_BAR; PG8_SCHED;
            PG8_LDB(B1, 1, 1); PG8_STAGE(PG8_SB(1, 0), b3, voffB);
            PG8_BAR; PG8_WAIT_L(0); PG8_MMA(0, 1, At, B1); PG8_BAR;
            PG8_LDA(At, 1, 1); PG8_STAGE(PG8_SA(1, 0), a3, voffA);
            PG8_BAR; PG8_WAIT_L(0); PG8_MMA(1, 0, At, B0); PG8_BAR; PG8_SCHED;
            PG8_STAGE(PG8_SB(1, 1), b3 + hstepB, voffB);
            PG8_WAIT_V(6); PG8_BAR; PG8_MMA(1, 1, At, B1); PG8_BAR;
        }
        E(acc, cur, wr, wc, fr, fq);
        if (!has_next) break;
#pragma unroll
        for (int a = 0; a < 2; ++a)
#pragma unroll
            for (int b = 0; b < 2; ++b)
#pragma unroll
                for (int m = 0; m < 4; ++m)
#pragma unroll
                    for (int n = 0; n < 2; ++n) acc[a][b][m][n] = (f32x4){0.f, 0.f, 0.f, 0.f};
        cur = nxt; cA = nA; cB = nB; ++ui;
    }
    PG8_WAIT_V(0);
    if (wr == 0) PG8_BAR;
    PG8_BAR;
#undef PG8_SA
#undef PG8_SB
#undef PG8_STAGE
#undef PG8_LDA
#undef PG8_LDB
#undef PG8_MMA
#undef PG8_WAIT_V
#undef PG8_WAIT_L
#undef PG8_BAR
#undef PG8_SCHED
}
}

template <int LNF, int ACT> struct EpiProj {
    static constexpr bool PERM = true;
    bf16_t* O; int ldc; const i64* stats; int ss_idx; const float* csum; const float* bw; i64* ssq;
    __device__ __forceinline__ void operator()(const f32x4 (&acc)[2][2][4][2], const pg8::Unit& u, int wr, int wc, int fr, int fq) const {
        const int row0 = u.pm * 256 + wr * 64 + fr, col0 = u.pn * 256 + wc * 32 + 8 * fq;
        const bool ln = (LNF == 0) && (stats != nullptr);
        typedef long long i64x2 __attribute__((ext_vector_type(2)));
        f32x4 cs[2][2], bv[2][2];
#pragma unroll
        for (int bj = 0; bj < 2; ++bj)
#pragma unroll
            for (int n = 0; n < 2; ++n) {
                cs[bj][n] = ln ? *(const f32x4*)(csum + col0 + bj * 128 + 4 * n) : (f32x4){0.f, 0.f, 0.f, 0.f};
                bv[bj][n] = ln ? *(const f32x4*)(bw + col0 + bj * 128 + 4 * n) : (f32x4){0.f, 0.f, 0.f, 0.f}; }
#pragma unroll
        for (int ai = 0; ai < 2; ++ai) {
            float mu_[4], rs_[4];
#pragma unroll
            for (int i = 0; i < 4; ++i) { const int row = row0 + ai * 128 + i * 16; mu_[i] = 0.f; rs_[i] = 1.f;
                if (LNF == 2 || ln) { const i64x2 sq = *(const i64x2*)(stats + row * 2);
                    if (LNF == 0) { mu_[i] = from_fx(sq[0], 1.f / DM); const float var = from_fx(sq[1], 1.f / DM) - mu_[i] * mu_[i]; rs_[i] = rsqrtf(var + LN_EPS); }
                    else rs_[i] = rsqrtf(from_fx(ss_idx ? sq[1] : sq[0], 1.f / 512.f) + RMS_EPS); } }
#pragma unroll
            for (int m = 0; m < 4; ++m) {
                const int row = row0 + ai * 128 + m * 16;
                const float rs = rs_[m], mu = mu_[m];
                float ssum = 0.f;
                bf16_t* rowp = O + (size_t)row * ldc + col0;
#pragma unroll
                for (int bj = 0; bj < 2; ++bj) {
                    f32x4 v0 = acc[ai][bj][m][0], v1 = acc[ai][bj][m][1];
                    if (LNF == 0) { v0 = rs * (v0 - mu * cs[bj][0]) + bv[bj][0]; v1 = rs * (v1 - mu * cs[bj][1]) + bv[bj][1]; }
                    else { v0 = rs * v0; v1 = rs * v1; }
                    if (ACT == 1) {
#pragma unroll
                        for (int j = 0; j < 4; ++j) { float a = fmaxf(v0[j], 0.f), b = fmaxf(v1[j], 0.f); v0[j] = a * a; v1[j] = b * b; } }
                    if (LNF == 0 && ACT == 0) {
#pragma unroll
                        for (int j = 0; j < 4; ++j) ssum += v0[j] * v0[j] + v1[j] * v1[j]; }
                    u32x4 w; w.x = cvt_pk_bf16(v0[0], v0[1]); w.y = cvt_pk_bf16(v0[2], v0[3]); w.z = cvt_pk_bf16(v1[0], v1[1]); w.w = cvt_pk_bf16(v1[2], v1[3]);
                    *(u32x4*)(rowp + bj * 128) = w; }
                if (LNF == 0 && ACT == 0) { if (ssq != nullptr) {
                    ssum += __shfl_xor(ssum, 16); ssum += __shfl_xor(ssum, 32);
                    if (fq == 0 && u.pn < 4) fx_add(ssq + row * 2 + (u.pn >> 1), ssum); } }
            }
        }
    }
};
struct EpiRes {
    static constexpr bool PERM = true;
    const float* src; float* Y; bf16_t* YB; const i64* stats_prev; const float* g; const float* b; i64* stats_new;
    __device__ __forceinline__ void operator()(const f32x4 (&acc)[2][2][4][2], const pg8::Unit& u, int wr, int wc, int fr, int fq) const {
        const int row0 = u.pm * 256 + wr * 64 + fr, col0 = u.pn * 256 + wc * 32 + 8 * fq;
        const bool ln = stats_prev != nullptr;
        typedef long long i64x2 __attribute__((ext_vector_type(2)));
        const float* __restrict__ srcr = src; float* __restrict__ Yr = Y; bf16_t* __restrict__ YBr = YB; const i64* __restrict__ spr = stats_prev;
        f32x4 gv[2][2], bv[2][2];
#pragma unroll
        for (int bj = 0; bj < 2; ++bj)
#pragma unroll
            for (int n = 0; n < 2; ++n) {
                gv[bj][n] = ln ? *(const f32x4*)(g + col0 + bj * 128 + 4 * n) : (f32x4){1.f, 1.f, 1.f, 1.f};
                bv[bj][n] = ln ? *(const f32x4*)(b + col0 + bj * 128 + 4 * n) : (f32x4){0.f, 0.f, 0.f, 0.f}; }
#pragma unroll
        for (int ai = 0; ai < 2; ++ai) {
            float mu_[4], rs_[4];
#pragma unroll
            for (int i = 0; i < 4; ++i) { const int row = row0 + ai * 128 + i * 16; mu_[i] = 0.f; rs_[i] = 1.f;
                if (ln) { const i64x2 sq = *(const i64x2*)(spr + row * 2);
                    mu_[i] = from_fx(sq[0], 1.f / DM); const float var = from_fx(sq[1], 1.f / DM) - mu_[i] * mu_[i]; rs_[i] = rsqrtf(var + LN_EPS); } }
#pragma unroll
            for (int m = 0; m < 4; ++m) {
                const int row = row0 + ai * 128 + m * 16;
                const float rs = rs_[m], mu = mu_[m];
                float s1 = 0.f, s2 = 0.f;
                const size_t ro = (size_t)row * DM + col0;
#pragma unroll
                for (int bj = 0; bj < 2; ++bj) {
                    const f32x4 p0 = *(const f32x4*)(srcr + ro + bj * 128), p1 = *(const f32x4*)(srcr + ro + bj * 128 + 4);
                    const f32x4 h0 = (p0 - mu) * rs * gv[bj][0] + bv[bj][0], h1 = (p1 - mu) * rs * gv[bj][1] + bv[bj][1];
                    const f32x4 y0 = ALPHA * h0 + acc[ai][bj][m][0], y1 = ALPHA * h1 + acc[ai][bj][m][1];
                    *(f32x4*)(Yr + ro + bj * 128) = y0; *(f32x4*)(Yr + ro + bj * 128 + 4) = y1;
#pragma unroll
                    for (int j = 0; j < 4; ++j) { s1 += y0[j] + y1[j]; s2 += y0[j] * y0[j] + y1[j] * y1[j]; }
                    u32x4 w; w.x = cvt_pk_bf16(y0[0], y0[1]); w.y = cvt_pk_bf16(y0[2], y0[3]); w.z = cvt_pk_bf16(y1[0], y1[1]); w.w = cvt_pk_bf16(y1[2], y1[3]);
                    *(u32x4*)(YBr + ro + bj * 128) = w; }
                s1 += __shfl_xor(s1, 16); s1 += __shfl_xor(s1, 32); s2 += __shfl_xor(s2, 16); s2 += __shfl_xor(s2, 32);
                if (fq == 0) { fx_add(stats_new + row * 2, s1); fx_add(stats_new + row * 2 + 1, s2); }
            }
        }
    }
};

__device__ __forceinline__ void prep_item(LAS unsigned char* lds, const WDesc& d, int item) {
    const int tid = ltid(), kp = tid >> 4, cc = tid & 15;
    const int nkc = d.K / d.kchunk, strip = item / nkc, kc = item % nkc;
    const int n0 = strip * 128, k0 = kc * d.kchunk, k1 = k0 + d.kchunk, N = d.N, K = d.K;
    const bool inr = (n0 + cc * 8) < N;
    const bool docs = d.csum != nullptr;
    float cs[8], bs[8];
#pragma unroll
    for (int j = 0; j < 8; ++j) { cs[j] = 0.f; bs[j] = 0.f; }
    int buf = 0;
    f32x4 na0 = {0.f, 0.f, 0.f, 0.f}, na1 = na0, nb0 = na0, nb1 = na0; float ng0 = 1.f, ng1 = 1.f, ne0 = 0.f, ne1 = 0.f;
#define PREP_LOAD(kt_) do { const int ka_ = (kt_) + 2 * kp; \
        if (inr) { const float* p0 = d.W + (size_t)ka_ * N + n0 + cc * 8; na0 = *(const f32x4*)p0; na1 = *(const f32x4*)(p0 + 4); nb0 = *(const f32x4*)(p0 + N); nb1 = *(const f32x4*)(p0 + N + 4); } \
        if (d.g) { ng0 = d.g[ka_]; ng1 = d.g[ka_ + 1]; } if (d.bvec) { ne0 = d.bvec[ka_]; ne1 = d.bvec[ka_ + 1]; } } while (0)
    PREP_LOAD(k0);
    for (int kt = k0; kt < k1; kt += 64) {
        const f32x4 a0 = na0, a1 = na1, b0 = nb0, b1 = nb1; const float g0 = ng0, g1 = ng1, e0 = ne0, e1 = ne1;
        if (kt + 64 < k1) PREP_LOAD(kt + 64);
        LAS unsigned* Tb = (LAS unsigned*)(lds + buf * 16896);
#pragma unroll
        for (int j = 0; j < 8; ++j) {
            const float x0 = j < 4 ? a0[j & 3] : a1[j & 3], x1 = j < 4 ? b0[j & 3] : b1[j & 3];
            const unsigned pk = cvt_pk_bf16(x0 * g0, x1 * g1);
            if (docs) { cs[j] += bf_lo(pk) + bf_hi(pk); bs[j] += e0 * x0 + e1 * x1; }
            Tb[(cc * 8 + j) * 33 + kp] = pk; }
        __syncthreads();
#pragma unroll
        for (int i = 0; i < 2; ++i) { const int id = tid + 512 * i, n = id >> 3, ch = id & 7;
            u32x4 v; v.x = Tb[n * 33 + ch * 4]; v.y = Tb[n * 33 + ch * 4 + 1]; v.z = Tb[n * 33 + ch * 4 + 2]; v.w = Tb[n * 33 + ch * 4 + 3];
            *(u32x4*)(d.WT + (size_t)(n0 + n) * K + kt + ch * 8) = v; }
        buf ^= 1;
    }
#undef PREP_LOAD
    if (docs) {
        LAS float* red = (LAS float*)(lds + 34816);
#pragma unroll
        for (int j = 0; j < 8; ++j) { red[kp * 128 + cc * 8 + j] = cs[j]; red[4096 + kp * 128 + cc * 8 + j] = bs[j]; }
        __syncthreads();
        if (tid < 256) { const int which = tid >> 7, n = tid & 127; float s = 0.f;
            for (int k = 0; k < 32; ++k) s += red[which * 4096 + k * 128 + n];
            (which ? d.bw : d.csum)[n0 + n] = s; }
    }
    __syncthreads();
}

__device__ __attribute__((noinline)) void rope_entry(float* rt, int i) {
          const int pos = i >> 5, fi = i & 31;
          double inv = 1.0; for (int k = 0; k < fi; ++k) inv *= 0.7498942093324559;
          const double ang = (double)pos * inv;
          const double n2 = __builtin_rint(ang * 0.15915494309189535);
          double r = ang - n2 * 6.283185307179586;
          const double kq = __builtin_rint(r * 0.6366197723675814);
          const double t = r - kq * 1.5707963267948966;
          const double t2 = t * t;
          const double s = t * (1.0 + t2 * (-1.0 / 6 + t2 * (1.0 / 120 + t2 * (-1.0 / 5040 + t2 * (1.0 / 362880 + t2 * (-1.0 / 39916800 + t2 * (1.0 / 6227020800.0)))))));
          const double c = 1.0 + t2 * (-0.5 + t2 * (1.0 / 24 + t2 * (-1.0 / 720 + t2 * (1.0 / 40320 + t2 * (-1.0 / 3628800 + t2 * (1.0 / 479001600.0))))));
          const int q = ((int)kq) & 3;
          const double sn = q == 0 ? s : (q == 1 ? c : (q == 2 ? -s : -c));
          const double cn = q == 0 ? c : (q == 1 ? -s : (q == 2 ? -c : s));
          rt[i] = (float)cn; rt[SEQ * 32 + i] = (float)sn;
}
__device__ __forceinline__ void phase_prep(LAS unsigned char* lds, const Params& p) {
    const int tid = ltid();
    const int gtid = lbid() * 512 + tid, gsz = lgdim() * 512;
    { i64* st = (i64*)(p.ws + OFF_STATS); for (int i = gtid; i < ST_TOTAL; i += gsz) st[i] = 0; }
    { float* rt = (float*)(p.ws + OFF_ROPE);
      for (int i = gtid; i < SEQ * 32; i += gsz) rope_entry(rt, i); }
    { const f32x4* x4 = (const f32x4*)p.in[0]; u32x2* yb = (u32x2*)(p.ws + OFF_YB);
      for (int i = gtid; i < T_ * DM / 4; i += gsz) { const f32x4 v = x4[i]; u32x2 o; o.x = cvt_pk_bf16(v[0], v[1]); o.y = cvt_pk_bf16(v[2], v[3]); yb[i] = o; } }
    for (int it = lbid(); it < p.main_items; it += lgdim()) {
        int di = 0;
        for (int k = 1; k < p.nwd; ++k) if (it >= p.wd[k].item0) di = k;
        prep_item(lds, p.wd[di], it - p.wd[di].item0);
    }
}
__device__ __forceinline__ void phase_prep_deferred(LAS unsigned char* lds, const Params& p, int first_idle) {
    const int c = lbid(), nidle = lgdim() - first_idle;
    if (c < first_idle) return;
    for (int it = p.main_items + (c - first_idle); it < p.total_items; it += nidle) {
        int di = 0;
        for (int k = 1; k < p.nwd; ++k) if (it >= p.wd[k].item0) di = k;
        prep_item(lds, p.wd[di], it - p.wd[di].item0);
    }
}

__device__ __forceinline__ int crow(int r, int hi) { return (r & 3) + 8 * (r >> 2) + 4 * hi; }
__device__ __forceinline__ float xhalf_(float v, int hi) { const auto rr = __builtin_amdgcn_permlane32_swap(__float_as_uint(v), __float_as_uint(v), false, false); return __uint_as_float(hi ? rr[0] : rr[1]); }
#define xhalf(v) xhalf_((v), hi)
#define MFMA32(a, b, c) __builtin_amdgcn_mfma_f32_32x32x16_bf16((a), (b), (c), 0, 0, 0)

#define DS_RD128(dst, addr, OFF) asm volatile("ds_read_b128 %0, %1 offset:%2" : "=v"(dst) : "v"(addr), "n"(OFF))
#define DS_RDTR(dst, addr, OFF)  asm volatile("ds_read_b64_tr_b16 %0, %1 offset:%2" : "=v"(dst) : "v"(addr), "n"(OFF))
#define LGKM_WAIT4(N, a, b, c, d) asm volatile("s_waitcnt lgkmcnt(" #N ")" : "+v"(a), "+v"(b), "+v"(c), "+v"(d))
#define LGKM_WAIT6(N, a, b, c, d, e, f) asm volatile("s_waitcnt lgkmcnt(" #N ")" : "+v"(a), "+v"(b), "+v"(c), "+v"(d), "+v"(e), "+v"(f))
#define LGKM_WAIT8(N, a, b, c, d, e, f, g, h) asm volatile("s_waitcnt lgkmcnt(" #N ")" : "+v"(a), "+v"(b), "+v"(c), "+v"(d), "+v"(e), "+v"(f), "+v"(g), "+v"(h))
#define SKEW_SLEEP 10
template <int V> struct IC { static constexpr int value = V; };
struct AttnArgs { const bf16_t* q; const bf16_t* kv; const bf16_t* kr; const float* rope; const float* bias; bf16_t* o; };

template <int MODE>
__device__ __forceinline__ void attn_phase(LAS unsigned char* lds, const AttnArgs& a) {
    constexpr int DQK = MODE == 0 ? 192 : 128, ND0 = DQK / 16, KSTR = 272, VSTR = 288, RSTR = 144;
    constexpr int KOFF = 0, VOFF = 64 * KSTR, ROFF = VOFF + 64 * VSTR, BUF = ROFF + (MODE == 0 ? 64 * RSTR : 0);
    constexpr int NI_K = 17, NI_V = 18, NI_R = MODE == 0 ? 9 : 0, NI = NI_K + NI_V + NI_R, NPW = (NI + 7) / 8;
    constexpr int LDQ = MODE == 0 ? 3072 : 6144, LDKV = MODE == 0 ? 4096 : 6144;
    constexpr float SC = MODE == 0 ? 0.07216878364870322f : 0.08838834764831845f;
    constexpr float C2 = SC * LOG2E;
    int tid = threadIdx.x; asm volatile("" : "+v"(tid));
    const int wid = __builtin_amdgcn_readfirstlane(tid >> 6), lane = tid & 63, r32 = lane & 31, hi = lane >> 5;
    const int i16 = lane & 15, q4 = i16 >> 2, p4 = i16 & 3, blk = (lane >> 4) & 1;
    LAS float* tb = (LAS float*)(lds + 2 * BUF);
    constexpr int QR_OFF = 2 * BUF + 768, NQR = ND0;
    unsigned voff[NPW];
#pragma unroll
    for (int i = 0; i < NPW; ++i) { const int j = wid + 8 * i;
        if (j < NI_K) { const int c = j * 64 + lane, row = c / 17, cc = c % 17; voff[i] = (unsigned)(row * (LDKV * 2) + (cc < 16 ? cc * 16 : 0)); }
        else if (j < NI_K + NI_V) { const int c = (j - NI_K) * 64 + lane, row = c / 18, cc = c % 18; voff[i] = (unsigned)(row * (LDKV * 2) + (cc < 16 ? cc * 16 : 0)); }
        else { const int c = (j - NI_K - NI_V) * 64 + lane, row = c / 9, cc = c % 9; voff[i] = (unsigned)(row * 128 + (cc < 8 ? cc * 16 : 0)); } }
    for (int bid_ = lbid(); bid_ < 256; bid_ += lgdim()) {
        const int it = bid_;
        const int bh = it >> 2, gp = it & 3, b = bh >> 4, h = bh & 15, tok0 = b * SEQ;
        for (int half = 0; half < 2; ++half) {
            const int g = half ? 7 - gp : gp;
            const int q0 = g * 256 + wid * 32, cw = q0 >> 6, qin = (q0 & 63) + r32;
            const char* kbase = (const char*)(MODE == 0 ? a.kv + h * 256 : a.q + 2048 + h * 128) + (size_t)tok0 * (LDKV * 2);
            const char* vbase_g = kbase + (MODE == 0 ? 256 : 4096);
            const char* rbase = (const char*)a.kr + (size_t)tok0 * 128;
#define ST_ISSUE(kc, bufi) do { _Pragma("unroll") for (int i_ = 0; i_ < NPW; ++i_) { const int j_ = wid + 8 * i_; if (j_ < NI) { \
    const char* src_; int dst_; \
    if (j_ < NI_K) { src_ = kbase + (size_t)(kc) * (64 * LDKV * 2); dst_ = KOFF + j_ * 1024; } \
    else if (j_ < NI_K + NI_V) { src_ = vbase_g + (size_t)(kc) * (64 * LDKV * 2); dst_ = VOFF + (j_ - NI_K) * 1024; } \
    else { src_ = rbase + (size_t)(kc) * (64 * 128); dst_ = ROFF + (j_ - NI_K - NI_V) * 1024; } \
    __builtin_amdgcn_global_load_lds((const unsigned*)(src_ + voff[i_]), (LAS unsigned*)(lds + (bufi) * BUF + dst_), 16, 0, 0); } } } while (0)
            const int kc_lo = MODE == 2 ? (4 * g - 8 > 0 ? 4 * g - 8 : 0) : 0, kc_hi = 4 * g + 3, nt = kc_hi - kc_lo + 1;
            ST_ISSUE((MODE == 1 ? kc_hi : kc_lo), 0);
            bf16x8 qr[ND0];
            { int ln = lane; asm volatile("" : "+v"(ln)); const int r32q = ln & 31, hiq = ln >> 5;
              const bf16_t* qp = a.q + (size_t)(tok0 + q0 + r32q) * LDQ + (MODE == 0 ? h * 192 : h * 128) + hiq * 8;
#pragma unroll
              for (int d0 = 0; d0 < ND0; ++d0) qr[d0] = *(const bf16x8*)(qp + d0 * 16);
              if (MODE == 0) {
                  const float* ct = a.rope + (size_t)(q0 + r32q) * 32 + hiq * 8; const float* st = ct + SEQ * 32;
#pragma unroll
                  for (int e = 0; e < 2; ++e) {
                      const f32x4 c0 = *(const f32x4*)(ct + e * 16), c1 = *(const f32x4*)(ct + e * 16 + 4), s0 = *(const f32x4*)(st + e * 16), s1 = *(const f32x4*)(st + e * 16 + 4);
                      const u32x4 x1 = __builtin_bit_cast(u32x4, qr[8 + e]), x2 = __builtin_bit_cast(u32x4, qr[10 + e]);
                      u32x4 o1, o2;
#pragma unroll
                      for (int w = 0; w < 4; ++w) {
                          const float ca = w < 2 ? c0[2 * w] : c1[2 * w - 4], cb = w < 2 ? c0[2 * w + 1] : c1[2 * w - 3];
                          const float sa = w < 2 ? s0[2 * w] : s1[2 * w - 4], sb = w < 2 ? s0[2 * w + 1] : s1[2 * w - 3];
                          const float a1 = bf_lo(x1[w]), b1 = bf_hi(x1[w]), a2 = bf_lo(x2[w]), b2 = bf_hi(x2[w]);
                          o1[w] = cvt_pk_bf16(a1 * ca - a2 * sa, b1 * cb - b2 * sb);
                          o2[w] = cvt_pk_bf16(a2 * ca + a1 * sa, b2 * cb + b1 * sb); }
                      qr[8 + e] = __builtin_bit_cast(bf16x8, o1); qr[10 + e] = __builtin_bit_cast(bf16x8, o2); } } }
            if (MODE == 0) {
#pragma unroll
                for (int f = 0; f < ND0 - NQR; ++f) *(LAS bf16x8*)(lds + QR_OFF + f * 8192 + tid * 16) = qr[NQR + f];
            }
            if (MODE == 2) { if (tid < 192) tb[tid] = a.bias[tid * 16 + h] * LOG2E; }
            f32x16 od[4];
#pragma unroll
            for (int d = 0; d < 4; ++d)
#pragma unroll
                for (int r = 0; r < 16; ++r) od[d][r] = 0.f;
            float m_run = -1e30f, l_run = 0.f, carry = 0.f;
            asm volatile("s_waitcnt vmcnt(0)" ::: "memory");
            __syncthreads();
            auto tile_step = [&](auto CURC, const int i) __attribute__((always_inline)) -> bool {
                constexpr int CUR = decltype(CURC)::value;
                const int kc = MODE == 1 ? kc_hi - i : kc_lo + i;
                if (i + 1 < nt) ST_ISSUE((MODE == 1 ? kc - 1 : kc + 1), (1 - CUR));
                const bool active = MODE == 2 ? (kc <= cw && kc >= cw - 8) : (kc <= cw);
                if (active) {
                    if (((wid >> 2) & 1) != 0) __builtin_amdgcn_s_sleep(SKEW_SLEEP);
                    LAS unsigned char* Kb = lds + CUR * BUF;
                    f32x16 p0, p1;
#pragma unroll
                    for (int r = 0; r < 16; ++r) { p0[r] = 0.f; p1[r] = 0.f; }
                    {
                        const unsigned ka = (unsigned)(size_t)(Kb + KOFF + r32 * KSTR + hi * 16), ra = (unsigned)(size_t)(Kb + ROFF + r32 * RSTR + hi * 16);
                        const unsigned pa = (unsigned)(size_t)(lds + QR_OFF + tid * 16);
                        bf16x8 kA0, kA1, kA2, kA3, kB0, kB1, kB2, kB3, qA0, qA1, qB0, qB1;
#define QK_LD(k0_, k1_, k2_, k3_, q0_, q1_, PJ) do { \
    if ((PJ) < 4) { DS_RD128(k0_, ka, (2 * (PJ)) * 32); DS_RD128(k1_, ka, (2 * (PJ)) * 32 + 32 * KSTR); DS_RD128(k2_, ka, (2 * (PJ) + 1) * 32); DS_RD128(k3_, ka, (2 * (PJ) + 1) * 32 + 32 * KSTR); } \
    else { DS_RD128(k0_, ra, (2 * ((PJ) & 3)) * 32); DS_RD128(k1_, ra, (2 * ((PJ) & 3)) * 32 + 32 * RSTR); DS_RD128(k2_, ra, (2 * ((PJ) & 3) + 1) * 32); DS_RD128(k3_, ra, (2 * ((PJ) & 3) + 1) * 32 + 32 * RSTR); \
           } } while (0)
#define QK_MM(k0_, k1_, k2_, k3_, q0_, q1_, PJ) do { \
    const bf16x8 qa_ = qr[(2 * (PJ)) < ND0 ? 2 * (PJ) : 0], qb_ = qr[(2 * (PJ) + 1) < ND0 ? 2 * (PJ) + 1 : 0]; \
    p0 = MFMA32(k0_, qa_, p0); p1 = MFMA32(k1_, qa_, p1); p0 = MFMA32(k2_, qb_, p0); p1 = MFMA32(k3_, qb_, p1); } while (0)
                        QK_LD(kA0, kA1, kA2, kA3, qA0, qA1, 0);
                        QK_LD(kB0, kB1, kB2, kB3, qB0, qB1, 1);
                        LGKM_WAIT4(4, kA0, kA1, kA2, kA3); __builtin_amdgcn_sched_barrier(0);
                        QK_MM(kA0, kA1, kA2, kA3, qA0, qA1, 0); __builtin_amdgcn_sched_barrier(0);
                        QK_LD(kA0, kA1, kA2, kA3, qA0, qA1, 2);
                        LGKM_WAIT4(4, kB0, kB1, kB2, kB3); __builtin_amdgcn_sched_barrier(0);
                        QK_MM(kB0, kB1, kB2, kB3, qB0, qB1, 1); __builtin_amdgcn_sched_barrier(0);
                        QK_LD(kB0, kB1, kB2, kB3, qB0, qB1, 3);
                        LGKM_WAIT4(4, kA0, kA1, kA2, kA3); __builtin_amdgcn_sched_barrier(0);
                        QK_MM(kA0, kA1, kA2, kA3, qA0, qA1, 2); __builtin_amdgcn_sched_barrier(0);
                        if (MODE == 0) {
                            QK_LD(kA0, kA1, kA2, kA3, qA0, qA1, 4);
                            LGKM_WAIT4(4, kB0, kB1, kB2, kB3); __builtin_amdgcn_sched_barrier(0);
                            QK_MM(kB0, kB1, kB2, kB3, qB0, qB1, 3); __builtin_amdgcn_sched_barrier(0);
                            QK_LD(kB0, kB1, kB2, kB3, qB0, qB1, 5);
                            LGKM_WAIT4(4, kA0, kA1, kA2, kA3); __builtin_amdgcn_sched_barrier(0);
                            QK_MM(kA0, kA1, kA2, kA3, qA0, qA1, 4); __builtin_amdgcn_sched_barrier(0);
                            LGKM_WAIT4(0, kB0, kB1, kB2, kB3); __builtin_amdgcn_sched_barrier(0);
                            QK_MM(kB0, kB1, kB2, kB3, qB0, qB1, 5); __builtin_amdgcn_sched_barrier(0);
                        } else {
                            LGKM_WAIT4(0, kB0, kB1, kB2, kB3); __builtin_amdgcn_sched_barrier(0);
                            QK_MM(kB0, kB1, kB2, kB3, qB0, qB1, 3); __builtin_amdgcn_sched_barrier(0);
                        }
#undef QK_LD
#undef QK_MM
                    }
                    if (MODE == 1) {
                        const bool diag = kc == cw;
#pragma unroll
                        for (int sub = 1; sub >= 0; --sub) {
                            f32x16& p = sub ? p1 : p0;
                            float l1[16], G[4], PG[4];
#pragma unroll
                            for (int r = 0; r < 16; ++r) {
                                const float z = p[r] * C2, e = __builtin_amdgcn_exp2f(-fabsf(z)), L = __builtin_amdgcn_logf(1.f + e);
                                float lb = fminf(z, 0.f) - L, lm = fminf(-z, 0.f) - L;
                                if (diag) { const bool valid = (sub * 32 + crow(r, hi)) < qin; lb = valid ? lb : -1e30f; lm = valid ? lm : 0.f; }
                                p[r] = lb; l1[r] = lm; }
#pragma unroll
                            for (int gi = 0; gi < 4; ++gi) { G[gi] = (l1[4 * gi] + l1[4 * gi + 1]) + (l1[4 * gi + 2] + l1[4 * gi + 3]); PG[gi] = xhalf(G[gi]); }
                            float run = carry;
#pragma unroll
                            for (int gi = 3; gi >= 0; --gi) {
                                const float s3 = hi ? run : run + PG[gi];
                                const float s2 = s3 + l1[4 * gi + 3], s1 = s2 + l1[4 * gi + 2], s0 = s1 + l1[4 * gi + 1];
                                p[4 * gi + 3] = __builtin_amdgcn_exp2f(p[4 * gi + 3] + s3); p[4 * gi + 2] = __builtin_amdgcn_exp2f(p[4 * gi + 2] + s2);
                                p[4 * gi + 1] = __builtin_amdgcn_exp2f(p[4 * gi + 1] + s1); p[4 * gi] = __builtin_amdgcn_exp2f(p[4 * gi] + s0);
                                run += G[gi] + PG[gi]; }
                            carry = run; }
                    } else {
                        if (MODE == 2) {
                            if (kc >= cw - 2) {
                                const int rel0 = kc * 64 - (q0 + r32);
#pragma unroll
                                for (int r = 0; r < 16; ++r) {
                                    int i0 = rel0 + crow(r, hi), i1 = i0 + 32;
                                    i0 = (i0 < -128 ? -128 : (i0 > 63 ? 63 : i0)) + 128; i1 = (i1 < -128 ? -128 : (i1 > 63 ? 63 : i1)) + 128;
                                    p0[r] = p0[r] * C2 + tb[i0]; p1[r] = p1[r] * C2 + tb[i1]; }
                            } else { const float b0 = tb[0];
#pragma unroll
                                for (int r = 0; r < 16; ++r) { p0[r] = p0[r] * C2 + b0; p1[r] = p1[r] * C2 + b0; } }
                        } else {
#pragma unroll
                            for (int r = 0; r < 16; ++r) { p0[r] *= C2; p1[r] *= C2; }
                        }
                        float mx = p0[0];
#pragma unroll
                        for (int r = 1; r < 16; ++r) mx = fmaxf(mx, p0[r]);
#pragma unroll
                        for (int r = 0; r < 16; ++r) mx = fmaxf(mx, p1[r]);
                        mx = fmaxf(mx, xhalf(mx));
                        const float mn = fmaxf(m_run, mx), al = __builtin_amdgcn_exp2f(m_run - mn);
                        m_run = mn;
                        float ps = 0.f;
#pragma unroll
                        for (int r = 0; r < 16; ++r) { p0[r] = __builtin_amdgcn_exp2f(p0[r] - mn); p1[r] = __builtin_amdgcn_exp2f(p1[r] - mn); ps += p0[r] + p1[r]; }
                        ps += xhalf(ps);
                        l_run = l_run * al + ps;
                        if (__any(al != 1.f)) {
#pragma unroll
                            for (int d = 0; d < 4; ++d)
#pragma unroll
                                for (int r = 0; r < 16; ++r) od[d][r] *= al; }
                    }
                    bf16x8 pb[4];
#pragma unroll
                    for (int s = 0; s < 4; ++s) { const f32x16& p = s < 2 ? p0 : p1; const int o = (s & 1) * 8;
                        u32x4 w; w.x = cvt_pk_bf16(p[o], p[o + 1]); w.y = cvt_pk_bf16(p[o + 2], p[o + 3]); w.z = cvt_pk_bf16(p[o + 4], p[o + 5]); w.w = cvt_pk_bf16(p[o + 6], p[o + 7]);
                        pb[s] = __builtin_bit_cast(bf16x8, w); }
                    LAS unsigned char* vbase = Kb + VOFF + (4 * hi + q4) * VSTR + blk * 32 + p4 * 8;
                    {
                        const unsigned va = (unsigned)(size_t)vbase;
                        s16x4 lA0, lA1, lA2, lA3, hA0, hA1, hA2, hA3, lB0, lB1, lB2, lB3, hB0, hB1, hB2, hB3;
#define PV_LD(l0, l1, l2, l3, h0, h1, h2, h3, D_) do { \
    DS_RDTR(l0, va, 0 * 16 * VSTR + (D_) * 64); DS_RDTR(h0, va, (0 * 16 + 8) * VSTR + (D_) * 64); DS_RDTR(l1, va, 1 * 16 * VSTR + (D_) * 64); DS_RDTR(h1, va, (1 * 16 + 8) * VSTR + (D_) * 64); \
    DS_RDTR(l2, va, 2 * 16 * VSTR + (D_) * 64); DS_RDTR(h2, va, (2 * 16 + 8) * VSTR + (D_) * 64); DS_RDTR(l3, va, 3 * 16 * VSTR + (D_) * 64); DS_RDTR(h3, va, (3 * 16 + 8) * VSTR + (D_) * 64); } while (0)
#define PV_MM(l0, l1, l2, l3, h0, h1, h2, h3, D_) do { \
    od[D_] = MFMA32(__builtin_shufflevector(l0, h0, 0, 1, 2, 3, 4, 5, 6, 7), pb[0], od[D_]); od[D_] = MFMA32(__builtin_shufflevector(l1, h1, 0, 1, 2, 3, 4, 5, 6, 7), pb[1], od[D_]); \
    od[D_] = MFMA32(__builtin_shufflevector(l2, h2, 0, 1, 2, 3, 4, 5, 6, 7), pb[2], od[D_]); od[D_] = MFMA32(__builtin_shufflevector(l3, h3, 0, 1, 2, 3, 4, 5, 6, 7), pb[3], od[D_]); } while (0)
                        PV_LD(lA0, lA1, lA2, lA3, hA0, hA1, hA2, hA3, 0);
                        PV_LD(lB0, lB1, lB2, lB3, hB0, hB1, hB2, hB3, 1);
                        LGKM_WAIT8(8, lA0, lA1, lA2, lA3, hA0, hA1, hA2, hA3); __builtin_amdgcn_sched_barrier(0);
                        PV_MM(lA0, lA1, lA2, lA3, hA0, hA1, hA2, hA3, 0); __builtin_amdgcn_sched_barrier(0);
                        PV_LD(lA0, lA1, lA2, lA3, hA0, hA1, hA2, hA3, 2);
                        LGKM_WAIT8(8, lB0, lB1, lB2, lB3, hB0, hB1, hB2, hB3); __builtin_amdgcn_sched_barrier(0);
                        PV_MM(lB0, lB1, lB2, lB3, hB0, hB1, hB2, hB3, 1); __builtin_amdgcn_sched_barrier(0);
                        PV_LD(lB0, lB1, lB2, lB3, hB0, hB1, hB2, hB3, 3);
                        LGKM_WAIT8(8, lA0, lA1, lA2, lA3, hA0, hA1, hA2, hA3); __builtin_amdgcn_sched_barrier(0);
                        PV_MM(lA0, lA1, lA2, lA3, hA0, hA1, hA2, hA3, 2); __builtin_amdgcn_sched_barrier(0);
                        LGKM_WAIT8(0, lB0, lB1, lB2, lB3, hB0, hB1, hB2, hB3); __builtin_amdgcn_sched_barrier(0);
                        PV_MM(lB0, lB1, lB2, lB3, hB0, hB1, hB2, hB3, 3); __builtin_amdgcn_sched_barrier(0);
#undef PV_LD
#undef PV_MM
                    }
                }
                asm volatile("s_waitcnt vmcnt(0)" ::: "memory");
                if (MODE == 1) {
                    if (__syncthreads_and((kc <= cw) && (carry <= -160.f))) return true;
                } else __syncthreads();
                return false;
            };
            for (int i = 0; i < nt; i += 2) {
                if (tile_step(IC<0>{}, i)) break;
                if (i + 1 < nt) { if (tile_step(IC<1>{}, i + 1)) break; }
            }
#undef ST_ISSUE
            const float inv = MODE == 1 ? 1.f : 1.f / l_run;
            int lo_ = lane; asm volatile("" : "+v"(lo_));
            bf16_t* op = a.o + (size_t)(tok0 + q0 + (lo_ & 31)) * DM + h * 128 + 4 * (lo_ >> 5);
#pragma unroll
            for (int d = 0; d < 4; ++d)
#pragma unroll
                for (int gq = 0; gq < 4; ++gq) {
                    u32x2 w; w.x = cvt_pk_bf16(od[d][4 * gq] * inv, od[d][4 * gq + 1] * inv); w.y = cvt_pk_bf16(od[d][4 * gq + 2] * inv, od[d][4 * gq + 3] * inv);
                    *(u32x2*)(op + d * 32 + 8 * gq) = w; }
            if (MODE == 1) __syncthreads();
        }
    }
}

__device__ __forceinline__ void krope_phase(const bf16_t* down, const float* rope, bf16_t* kr) {
    const size_t gtid = (size_t)lbid() * 512 + ltid(), gsz = (size_t)lgdim() * 512;
    for (size_t i = gtid; i < (size_t)T_ * 32; i += gsz) {
        const int t = (int)(i >> 5), fi = (int)(i & 31), pos = t & (SEQ - 1);
        const float c = rope[pos * 32 + fi], s = rope[SEQ * 32 + pos * 32 + fi];
        const float x1 = __uint_as_float((unsigned)down[(size_t)t * 1280 + 1024 + fi] << 16), x2 = __uint_as_float((unsigned)down[(size_t)t * 1280 + 1056 + fi] << 16);
        const unsigned o = cvt_pk_bf16(x1 * c - x2 * s, x2 * c + x1 * s);
        kr[(size_t)t * 64 + fi] = (bf16_t)(o & 0xffff); kr[(size_t)t * 64 + 32 + fi] = (bf16_t)(o >> 16); }
}

__device__ __forceinline__ void final_ln(const float* Y, const i64* stats, const float* g, const float* b, float* out) {
    const size_t gtid = (size_t)lbid() * 512 + ltid(), gsz = (size_t)lgdim() * 512;
    for (size_t i = gtid; i < (size_t)T_ * DM / 4; i += gsz) {
        const int row = (int)(i >> 9), c4 = (int)(i & 511);
        const float mu = from_fx(stats[row * 2], 1.f / DM), var = from_fx(stats[row * 2 + 1], 1.f / DM) - mu * mu, rs = rsqrtf(var + LN_EPS);
        const f32x4 v = ((const f32x4*)Y)[i], gg = ((const f32x4*)g)[c4], bb = ((const f32x4*)b)[c4];
        ((f32x4*)out)[i] = (v - mu) * rs * gg + bb; }
}


#define XB_TMO      128
#define XB_XCNT(j)  (256  + 64 * (j))
#define XB_XSUB(j)  (1280 + 64 * (j))
#define XB_XGEN(j)  (2304 + 64 * (j))
#define XB_TOP      3328
#define XB_TOPGEN   3392
#define XCD_BAR_WORDS 3456
#define XB_SPIN_CAP (1u << 18)
__device__ __forceinline__ unsigned xb_ld(unsigned* p)              { return __hip_atomic_load(p, __ATOMIC_RELAXED, __HIP_MEMORY_SCOPE_AGENT); }
__device__ __forceinline__ unsigned xb_add(unsigned* p, unsigned v) { return __hip_atomic_fetch_add(p, v, __ATOMIC_RELAXED, __HIP_MEMORY_SCOPE_AGENT); }
__device__ __forceinline__ unsigned xb_xcc_id() { return (unsigned)__builtin_amdgcn_s_getreg((3 << 11) | 20) & 0xFu; }
#define XB_SPIN(cond, bar) do { unsigned _sp = 0; while (cond) { __builtin_amdgcn_s_sleep(1); \
    if ((++_sp & 255u) == 0u) { if (xb_ld(&(bar)[XB_TMO])) break; if (_sp > XB_SPIN_CAP) { atomicAdd(&(bar)[XB_TMO], 1u); break; } } } } while (0)
__device__ __forceinline__ void xcd_barrier_complete(unsigned* bar, unsigned x, unsigned& nloc, unsigned& nx) {
    const unsigned G = gridDim.x;
    unsigned sum, cnt, mine, sp = 0u;
    for (;;) {
        sum = 0u; cnt = 0u; mine = 0u;
#pragma unroll
        for (unsigned j = 0; j < 16; ++j) { const unsigned c = xb_ld(&bar[XB_XCNT(j)]); sum += c; cnt += (c > 0u) ? 1u : 0u; mine = (j == x) ? c : mine; }
        if (sum == G) break;
        __builtin_amdgcn_s_sleep(1);
        if ((++sp & 255u) == 0u) { if (xb_ld(&bar[XB_TMO])) break; if (sp > XB_SPIN_CAP) { atomicAdd(&bar[XB_TMO], 1u); break; } }
    }
    nloc = mine > 0u ? mine : 1u; nx = cnt > 0u ? cnt : 1u;
}
__device__ __forceinline__ void xcd_barrier(unsigned* bar, volatile LAS unsigned* st) {
    asm volatile("s_waitcnt vmcnt(0)" ::: "memory");
    __syncthreads();
    if (threadIdx.x == 0) {
        const unsigned x = xb_xcc_id();
        __builtin_amdgcn_s_waitcnt(0);
        unsigned nloc = st[0], nx = st[1];
        if (nloc == 0u) { xcd_barrier_complete(bar, x, nloc, nx); st[0] = nloc; st[1] = nx; }
        const unsigned old = xb_add(&bar[XB_XSUB(x)], 1u);
        const unsigned gen = old / nloc;
        if (old + 1u == (gen + 1u) * nloc) {
            __builtin_amdgcn_fence(__ATOMIC_RELEASE, "agent");
            asm volatile("s_waitcnt vmcnt(0)" ::: "memory");
            const unsigned og = xb_add(&bar[XB_TOP], 1u);
            const unsigned tg = og / nx;
            if (og + 1u == (tg + 1u) * nx) xb_add(&bar[XB_TOPGEN], 1u);
            else XB_SPIN(xb_ld(&bar[XB_TOPGEN]) == tg, bar);
            __builtin_amdgcn_fence(__ATOMIC_ACQUIRE, "agent");
            xb_add(&bar[XB_XGEN(x)], 1u);
            asm volatile("s_waitcnt vmcnt(0)" ::: "memory");
        } else {
            XB_SPIN(xb_ld(&bar[XB_XGEN(x)]) == gen, bar);
            __builtin_amdgcn_fence(__ATOMIC_ACQUIRE, "agent");
            asm volatile("s_waitcnt vmcnt(0)" ::: "memory");
        }
    }
    __syncthreads();
}
__device__ __forceinline__ void run_phase(LAS unsigned char* lds, const Params& p, int code) {
    size_t zoff = 0; asm volatile("" : "+s"(zoff));
    unsigned char* ws = p.ws + zoff;
    const int layer = code >> 4, step = code & 15;
    const int kind = layer % 3, slot = layer / 3, sl_mix = 2 * layer, sl_ffn = 2 * layer + 1;
    float* vec = (float*)(ws + OFF_VEC);
    i64* stats = (i64*)(ws + OFF_STATS);
    const float* rope = (const float*)(ws + OFF_ROPE);
    float* Y = (float*)(ws + OFF_Y);
    bf16_t* YB = (bf16_t*)(ws + OFF_YB);
    bf16_t* QKV = (bf16_t*)(ws + OFF_QKV);
    bf16_t* OB = (bf16_t*)(ws + OFF_O);
    bf16_t* HID = (bf16_t*)(ws + OFF_HID);
    const i64* st_in = layer == 0 ? nullptr : stats + (size_t)(sl_mix - 1) * T_ * 2;
    const unsigned char* wm = ws + OFF_MLA + slot * MLA_SLOT;
    bf16_t* DOWN = (bf16_t*)((unsigned char*)QKV + QKV_DOWN); bf16_t* Qb = (bf16_t*)((unsigned char*)QKV + QKV_Q);
    bf16_t* KVb = (bf16_t*)((unsigned char*)QKV + QKV_KV); bf16_t* KRb = (bf16_t*)((unsigned char*)QKV + QKV_KR);
    i64* rowss = stats + ST_ROWSS + (size_t)slot * T_ * 2;
    pg8::StaticOrder S;
    switch (step) {
    case 0: phase_prep(lds, p); break;
    case 1: { pg8::Gemm g{YB, (const bf16_t*)(wm + MLA_DOWN), T_, 1280, DM, DM}; S.init(T_, 1280, lgdim(), lbid());
              EpiProj<0, 0> E{DOWN, 1280, st_in, 0, vec + V_MD_CS + slot * 1280, vec + V_MD_BW + slot * 1280, rowss};
              pg8::gemm_phase(lds, g, S, E);
              if (layer == 0) phase_prep_deferred(lds, p, 160); } break;
    case 2: { krope_phase(DOWN, rope, KRb);
              { pg8::Gemm g{DOWN, (const bf16_t*)(wm + MLA_UQ), T_, 3072, 512, 1280}; S.init(T_, 3072, lgdim(), lbid());
                EpiProj<2, 0> E{Qb, 3072, rowss, 0, nullptr, nullptr, nullptr};
                pg8::gemm_phase(lds, g, S, E); }
              { pg8::Gemm g{DOWN + 512, (const bf16_t*)(wm + MLA_UKV), T_, 4096, 512, 1280}; S.init(T_, 4096, lgdim(), lbid());
                EpiProj<2, 0> E{KVb, 4096, rowss, 1, nullptr, nullptr, nullptr};
                pg8::gemm_phase(lds, g, S, E); } } break;
    case 3: { AttnArgs a{Qb, KVb, KRb, rope, nullptr, OB}; attn_phase<0>(lds, a); } break;
    case 4: { const unsigned char* wq = ws + (kind == 1 ? OFF_SB : OFF_CA);
              pg8::Gemm g{YB, (const bf16_t*)wq, T_, 6144, DM, DM}; S.init(T_, 6144, lgdim(), lbid());
              EpiProj<0, 0> E{QKV, 6144, st_in, 0, vec + (kind == 1 ? V_SB_CS : V_CA_CS), vec + (kind == 1 ? V_SB_BW : V_CA_BW), nullptr};
              pg8::gemm_phase(lds, g, S, E); } break;
    case 5: { AttnArgs a{QKV, nullptr, nullptr, nullptr, nullptr, OB}; attn_phase<1>(lds, a); } break;
    case 6: { AttnArgs a{QKV, nullptr, nullptr, nullptr, p.in[16], OB}; attn_phase<2>(lds, a); } break;
    case 7: { const bf16_t* wo = (const bf16_t*)(kind == 0 ? ws + OFF_MLA + slot * MLA_SLOT + MLA_WO : (kind == 1 ? ws + OFF_SB + 24 * MB : ws + OFF_CA + 24 * MB));
              pg8::Gemm g{OB, wo, T_, DM, DM, DM}; S.init(T_, DM, lgdim(), lbid());
              const float* lg = layer == 0 ? nullptr : p.in[3] + (size_t)(layer - 1) * DM; const float* lb = layer == 0 ? nullptr : p.in[4] + (size_t)(layer - 1) * DM;
              EpiRes E{layer == 0 ? p.in[0] : Y, Y, YB, st_in, lg, lb, stats + (size_t)sl_mix * T_ * 2};
              pg8::gemm_phase(lds, g, S, E); } break;
    case 8: { pg8::Gemm g{YB, (const bf16_t*)(ws + OFF_WFI + (size_t)layer * 32 * MB), T_, DFF, DM, DM}; S.init(T_, DFF, lgdim(), lbid());
              EpiProj<0, 1> E{HID, DFF, stats + (size_t)sl_mix * T_ * 2, 0, vec + V_FI_CS + layer * 8192, vec + V_FI_BW + layer * 8192, nullptr};
              pg8::gemm_phase(lds, g, S, E); } break;
    case 9: { pg8::Gemm g{HID, (const bf16_t*)(ws + OFF_WFO + (size_t)layer * 32 * MB), T_, DM, DFF, DFF}; S.init(T_, DM, lgdim(), lbid());
              EpiRes E{Y, Y, YB, stats + (size_t)sl_mix * T_ * 2, p.in[1] + (size_t)layer * DM, p.in[2] + (size_t)layer * DM, stats + (size_t)sl_ffn * T_ * 2};
              pg8::gemm_phase(lds, g, S, E); } break;
    default: final_ln(Y, stats + (size_t)7 * T_ * 2, p.in[3] + 3 * DM, p.in[4] + 3 * DM, p.out); break;
    }
}

__global__ void __launch_bounds__(512, 2) fwd_megakernel(Params p) {
    extern __shared__ __attribute__((aligned(16))) unsigned char shm[];
    LAS unsigned char* lds = (LAS unsigned char*)shm;
    __builtin_assume(__builtin_amdgcn_workitem_id_y() == 0); __builtin_assume(__builtin_amdgcn_workitem_id_z() == 0);
    cg::grid_group grid = cg::this_grid();
    volatile LAS unsigned* st = (volatile LAS unsigned*)(lds + XB_ST_OFF);
    unsigned* bar = (unsigned*)(p.ws + OFF_BAR);
    if (threadIdx.x == 0) { st[0] = 0u; st[1] = 0u; (void)xb_add(&bar[XB_XCNT(xb_xcc_id())], 1u); }
    __syncthreads();
    for (int ph = p.ph_lo; ph < p.ph_hi; ++ph) {
        const int code = p.prog[ph];
        run_phase(lds, p, code);
        if (ph + 1 < p.ph_hi) { if (ph == p.ph_lo) grid.sync(); else xcd_barrier((unsigned*)(p.ws + OFF_BAR), st); }
    }
}

constexpr int LDS_BYTES = 155648;

extern "C" void kernel_launch(void* const* d_in, const int* in_sizes, int n_in, void* d_out, int out_size, void* d_ws, size_t ws_size, hipStream_t stream) {
    static int grid_blocks = 0;
    if (!grid_blocks) {
        int dev = 0, cus = 0, per_cu = 0;
        hipGetDevice(&dev);
        hipDeviceGetAttribute(&cus, hipDeviceAttributeMultiprocessorCount, dev);
        hipFuncSetAttribute((const void*)fwd_megakernel, hipFuncAttributeMaxDynamicSharedMemorySize, LDS_BYTES);
        hipOccupancyMaxActiveBlocksPerMultiprocessor(&per_cu, (const void*)fwd_megakernel, 512, LDS_BYTES);
        if (per_cu < 1) per_cu = 1;
        grid_blocks = cus * per_cu;
        if (ws_size < WS_END) fprintf(stderr, "workspace too small: %zu < %zu\n", ws_size, (size_t)WS_END);
    }
    Params p{};
    for (int i = 0; i < 18; ++i) p.in[i] = (const float*)d_in[i];
    p.out = (float*)d_out; p.ws = (unsigned char*)d_ws;
    unsigned char* ws = (unsigned char*)d_ws; float* vec = (float*)(ws + OFF_VEC);
    int n = 0, items = 0;
    auto add = [&](const float* W, void* WT, const float* g, const float* bvec, float* csum, float* bw, int K, int N, int Npad, int kchunk) {
        WDesc& d = p.wd[n++]; d.W = W; d.WT = (bf16_t*)WT; d.g = g; d.bvec = bvec; d.csum = csum; d.bw = bw; d.K = K; d.N = N; d.Npad = Npad; d.kchunk = kchunk;
        d.item0 = items; d.nitems = (Npad / 128) * (K / kchunk); items += d.nitems; };
    for (int l = 0; l < 4; ++l) add(p.in[5] + (size_t)l * DM * DFF, ws + OFF_WFI + (size_t)l * 32 * MB, p.in[1] + l * DM, p.in[2] + l * DM, vec + V_FI_CS + l * 8192, vec + V_FI_BW + l * 8192, DM, DFF, DFF, DM);
    for (int l = 0; l < 2; ++l) add(p.in[6] + (size_t)l * DM * DFF, ws + OFF_WFO + (size_t)l * 32 * MB, nullptr, nullptr, nullptr, nullptr, DFF, DM, DM, 2048);
    add(p.in[13], ws + OFF_SB, p.in[3] + 0 * DM, p.in[4] + 0 * DM, vec + V_SB_CS, vec + V_SB_BW, DM, 6144, 6144, DM);
    add(p.in[15], ws + OFF_CA, p.in[3] + 1 * DM, p.in[4] + 1 * DM, vec + V_CA_CS, vec + V_CA_BW, DM, 6144, 6144, DM);
    add(p.in[14], ws + OFF_SB + 24 * MB, nullptr, nullptr, nullptr, nullptr, DM, DM, DM, DM);
    add(p.in[17], ws + OFF_CA + 24 * MB, nullptr, nullptr, nullptr, nullptr, DM, DM, DM, DM);
    for (int s = 0; s < 2; ++s) add(p.in[12] + (size_t)s * DM * DM, ws + OFF_MLA + s * MLA_SLOT + MLA_WO, nullptr, nullptr, nullptr, nullptr, DM, DM, DM, DM);
    add(p.in[7], ws + OFF_MLA + MLA_DOWN, nullptr, nullptr, nullptr, nullptr, DM, 1088, 1280, DM);
    add(p.in[7] + (size_t)DM * 1088, ws + OFF_MLA + MLA_SLOT + MLA_DOWN, p.in[3] + 2 * DM, p.in[4] + 2 * DM, vec + V_MD_CS + 1280, vec + V_MD_BW + 1280, DM, 1088, 1280, DM);
    for (int s = 0; s < 2; ++s) add(p.in[9] + (size_t)s * 512 * 3072, ws + OFF_MLA + s * MLA_SLOT + MLA_UQ, p.in[8] + s * 512, nullptr, nullptr, nullptr, 512, 3072, 3072, 512);
    for (int s = 0; s < 2; ++s) add(p.in[11] + (size_t)s * 512 * 4096, ws + OFF_MLA + s * MLA_SLOT + MLA_UKV, p.in[10] + s * 512, nullptr, nullptr, nullptr, 512, 4096, 4096, 512);
    for (int l = 2; l < 4; ++l) add(p.in[6] + (size_t)l * DM * DFF, ws + OFF_WFO + (size_t)l * 32 * MB, nullptr, nullptr, nullptr, nullptr, DFF, DM, DM, 2048);
    p.nwd = n; p.total_items = items;
    p.main_items = grid_blocks > 160 ? items - (grid_blocks - 160) : items;
    int np = 0;
    p.prog[np++] = 0;
    for (int l = 0; l < 4; ++l) {
        const int kind = l % 3;
        if (kind == 0) { p.prog[np++] = (l << 4) | 1; p.prog[np++] = (l << 4) | 2; p.prog[np++] = (l << 4) | 3; }
        else { p.prog[np++] = (l << 4) | 4; p.prog[np++] = (l << 4) | (kind == 1 ? 5 : 6); }
        p.prog[np++] = (l << 4) | 7; p.prog[np++] = (l << 4) | 8; p.prog[np++] = (l << 4) | 9;
    }
    p.prog[np++] = 10;
    p.ph_lo = 0; p.ph_hi = np;
    hipMemsetAsync((unsigned char*)d_ws + OFF_BAR, 0, 3456 * 4, stream);
    void* args[] = {&p};
    hipError_t e = hipLaunchCooperativeKernel((const void*)fwd_megakernel, dim3(grid_blocks), dim3(512), args, LDS_BYTES, stream);
    if (e != hipSuccess) fprintf(stderr, "cooperative launch failed: %s (grid %d)\n", hipGetErrorString(e), grid_blocks);
}
```

```cpp
#include <hip/hip_runtime.h>
#include <hip/hip_cooperative_groups.h>
#include <cstdio>
namespace cg = cooperative_groups;

#define LAS __attribute__((address_space(3)))
typedef unsigned short bf16_t;
typedef short bf16x8 __attribute__((ext_vector_type(8)));
typedef short s16x4 __attribute__((ext_vector_type(4)));
typedef float f32x4 __attribute__((ext_vector_type(4)));
typedef float f32x16 __attribute__((ext_vector_type(16)));
typedef unsigned u32x4 __attribute__((ext_vector_type(4)));
typedef unsigned u32x2 __attribute__((ext_vector_type(2)));

constexpr int T_ = 8192, DM = 2048, DFF = 8192, SEQ = 2048;
constexpr float ALPHA = 1.6817928305074290f;
constexpr float LN_EPS = 1e-5f, RMS_EPS = 1e-6f;
constexpr float LOG2E = 1.4426950408889634f;

constexpr size_t MB = 1ull << 20;
constexpr size_t OFF_WFI = 0, OFF_WFO = 128 * MB, OFF_MLA = 256 * MB, OFF_SB = 296 * MB, OFF_CA = 328 * MB, OFF_VEC = 360 * MB,
                 OFF_STATS = 361 * MB, OFF_ROPE = 363 * MB, OFF_Y = 364 * MB, OFF_YB = 428 * MB, OFF_QKV = 460 * MB, OFF_O = 600 * MB,
                 OFF_HID = 632 * MB, WS_END = 760 * MB;
constexpr size_t OFF_BAR = OFF_STATS + 3 * MB / 2;
constexpr int XB_ST_OFF = 155648 - 16;
constexpr size_t MLA_SLOT = 20 * MB, MLA_DOWN = 0, MLA_UQ = 5 * MB, MLA_UKV = 8 * MB, MLA_WO = 12 * MB;
constexpr size_t QKV_DOWN = 0, QKV_Q = 20 * MB, QKV_KV = 68 * MB, QKV_KR = 132 * MB;
constexpr int V_FI_CS = 0, V_FI_BW = 4 * 8192, V_MD_CS = 8 * 8192, V_MD_BW = V_MD_CS + 2 * 1280, V_SB_CS = V_MD_BW + 2 * 1280, V_SB_BW = V_SB_CS + 6144,
              V_CA_CS = V_SB_BW + 6144, V_CA_BW = V_CA_CS + 6144;
constexpr int ST_ROWSS = 8 * T_ * 2, ST_TOTAL = 10 * T_ * 2;

struct WDesc { const float* W; bf16_t* WT; const float* g; const float* bvec; float* csum; float* bw; int K, N, Npad, kchunk, item0, nitems; };
struct Params {
    const float* in[18];
    float* out; unsigned char* ws;
    WDesc wd[20];
    int nwd, total_items, ph_lo, ph_hi;
    unsigned char prog[48];
};

__device__ __forceinline__ unsigned cvt_pk_bf16(float lo, float hi) { unsigned r; asm volatile("v_cvt_pk_bf16_f32 %0, %1, %2" : "=v"(r) : "v"(lo), "v"(hi)); return r; }
__device__ __forceinline__ int ltid() { int t = threadIdx.x; asm volatile("" : "+v"(t)); return t; }
__device__ __forceinline__ int lgdim() { int t = gridDim.x; asm volatile("" : "+s"(t)); return t; }
__device__ __forceinline__ int lbid() { int t = blockIdx.x; asm volatile("" : "+s"(t)); return t; }
typedef long long i64;
__device__ __forceinline__ i64 to_fx(float v) { const float fl = floorf(v); const unsigned lo = (unsigned)((v - fl) * 4294967296.0f); return (i64)(((unsigned long long)(unsigned)(int)fl << 32) | lo); }
__device__ __forceinline__ float from_fx(i64 v, float scale) { const int hi = (int)(v >> 32); const unsigned lo = (unsigned)v; return ((float)hi + (float)lo * 2.3283064365386963e-10f) * scale; }
__device__ __forceinline__ void fx_add(i64* p, float v) { atomicAdd((unsigned long long*)p, (unsigned long long)to_fx(v)); }
__device__ __forceinline__ float bf_lo(unsigned u) { return __uint_as_float(u << 16); }
__device__ __forceinline__ float bf_hi(unsigned u) { return __uint_as_float(u & 0xffff0000u); }

namespace pg8 {
constexpr int BM = 256, BK = 64, HALF = 128, HTB = HALF * BK * 2, STAGE_BYTES = 8 * HTB, NXCD = 8, WGM = 8;
__host__ __device__ __forceinline__ int lds_byte(int r, int c) { const int st = (r >> 4) * 2 + (c >> 5), rr = r & 15, cc = c & 31, ob = rr * 64 + cc * 2; return st * 1024 + (ob ^ (((ob >> 9) & 1) << 5)); }
__host__ __device__ __forceinline__ void stage_rc(int b, int& R, int& C) { const int st = b / 1024, sb = b % 1024, swz = sb ^ (((sb >> 9) & 1) << 5); R = (st >> 1) * 16 + swz / 64; C = (st & 1) * 32 + (swz % 64) / 2; }
__host__ __device__ __forceinline__ int perm32(int rho) { const int n = rho >> 4, i = rho & 15; return 8 * (i >> 2) + 4 * n + (i & 3); }
struct Unit { int pm, pn; };
struct Gemm { const bf16_t* A; const bf16_t* Bt; int M, N, K, lda; };
struct StaticOrder {
    int nM, nN, nwg, G, c;
    __device__ void init(int M, int N, int G_, int c_) { nM = M / BM; nN = N / BM; nwg = nM * nN; G = G_; c = c_; }
    __device__ bool next(int i, Unit& u) const {
        const long L = (long)i * G + c; if (L >= nwg) return false;
        int wgid = (int)L; { const int q = nwg / NXCD, r = nwg % NXCD, xcd = wgid % NXCD, off = wgid / NXCD; wgid = (xcd < r ? xcd * (q + 1) : r * (q + 1) + (xcd - r) * q) + off; }
        const int nig = WGM * nN, gid = wgid / nig, fm = gid * WGM, gsz = (nM - fm) < WGM ? (nM - fm) : WGM;
        u.pm = fm + ((wgid % nig) % gsz); u.pn = (wgid % nig) / gsz; return true;
    }
};

template <class Epi>
__device__ __forceinline__ void gemm_phase(LAS unsigned char* lds, const Gemm g, const StaticOrder& S, const Epi& E) {
    int tid = threadIdx.x; asm volatile("" : "+v"(tid));
    const int wid = __builtin_amdgcn_readfirstlane(tid >> 6), lane = tid & 63, wr = wid >> 2, wc = wid & 3, fr = lane & 15, fq = lane >> 4;
    const int K = g.K, nt = K / BK, lda = g.lda;
    unsigned voffA[2], voffB[2];
#pragma unroll
    for (int i = 0; i < 2; ++i) { int R, C; stage_rc(tid * 16 + i * 8192, R, C); const int Rb = Epi::PERM ? ((R & ~31) + perm32(R & 31)) : R;
        voffA[i] = (unsigned)(R * lda + C) * 2u; voffB[i] = (unsigned)(Rb * K + C) * 2u; }
    const size_t kstep = (size_t)(BK * 2);
    const size_t hstepA = (size_t)HALF * lda * 2, hstepB = (size_t)HALF * K * 2;
    const size_t tstepA = 2 * hstepA, tstepB = 2 * hstepB;
    const unsigned ldsw = (unsigned)wid * 1024u;
    const int aoff = lds_byte(wr * 64 + fr, fq * 8), boff = lds_byte(wc * 32 + fr, fq * 8);
#define PG8_SA(b, h) (((b) * 2 + (h)) * HTB)
#define PG8_SB(b, h) ((4 + (b) * 2 + (h)) * HTB)
#define PG8_STAGE(bufoff, gbase, voff) do { _Pragma("unroll") for (int _i = 0; _i < 2; ++_i) \
        __builtin_amdgcn_global_load_lds((const unsigned*)((const char*)(gbase) + (voff)[_i]), (LAS unsigned*)(lds + (bufoff) + ldsw + _i * 8192), 16, 0, 0); } while (0)
#define PG8_LDA(dst, b, h) do { _Pragma("unroll") for (int m = 0; m < 4; ++m) _Pragma("unroll") for (int k = 0; k < 2; ++k) dst[m][k] = *(const LAS bf16x8*)(lds + PG8_SA(b, h) + aoff + m * 2048 + k * 1024); } while (0)
#define PG8_LDB(dst, b, h) do { _Pragma("unroll") for (int n = 0; n < 2; ++n) _Pragma("unroll") for (int k = 0; k < 2; ++k) dst[n][k] = *(const LAS bf16x8*)(lds + PG8_SB(b, h) + boff + n * 2048 + k * 1024); } while (0)
#define PG8_MMA(ai, bj, At, Bt) do { __builtin_amdgcn_s_setprio(1); _Pragma("unroll") for (int m = 0; m < 4; ++m) _Pragma("unroll") for (int n = 0; n < 2; ++n) _Pragma("unroll") for (int k = 0; k < 2; ++k) \
        acc[ai][bj][m][n] = __builtin_amdgcn_mfma_f32_16x16x32_bf16(Bt[n][k], At[m][k], acc[ai][bj][m][n], 0, 0, 0); __builtin_amdgcn_s_setprio(0); } while (0)
#define PG8_WAIT_V(n) asm volatile("s_waitcnt vmcnt(" #n ")" ::: "memory")
#define PG8_WAIT_L(n) asm volatile("s_waitcnt lgkmcnt(" #n ")" ::: "memory")
#define PG8_BAR __builtin_amdgcn_s_barrier()
#define PG8_SCHED __builtin_amdgcn_sched_barrier(0)
    Unit cur, nxt; int ui = 0;
    if (!S.next(0, cur)) return;
    f32x4 acc[2][2][4][2];
#pragma unroll
    for (int a = 0; a < 2; ++a)
#pragma unroll
        for (int b = 0; b < 2; ++b)
#pragma unroll
            for (int m = 0; m < 4; ++m)
#pragma unroll
                for (int n = 0; n < 2; ++n) acc[a][b][m][n] = (f32x4){0.f, 0.f, 0.f, 0.f};
    bf16x8 At[4][2], B0[2][2], B1[2][2];
    const char* cA = (const char*)g.A + (size_t)cur.pm * tstepA; const char* cB = (const char*)g.Bt + (size_t)cur.pn * tstepB;
    PG8_STAGE(PG8_SB(0, 0), cB, voffB); PG8_STAGE(PG8_SA(0, 0), cA, voffA); PG8_STAGE(PG8_SB(0, 1), cB + hstepB, voffB); PG8_STAGE(PG8_SA(0, 1), cA + hstepA, voffA);
    if (wr == 1) PG8_BAR;
    PG8_WAIT_V(4); PG8_BAR;
    PG8_STAGE(PG8_SB(1, 0), cB + kstep, voffB); PG8_STAGE(PG8_SA(1, 0), cA + kstep, voffA); PG8_STAGE(PG8_SB(1, 1), cB + hstepB + kstep, voffB);
    PG8_WAIT_V(6); PG8_BAR;
    for (;;) {
        const bool has_next = S.next(ui + 1, nxt);
        const char* nA = has_next ? (const char*)g.A + (size_t)nxt.pm * tstepA : cA; const char* nB = has_next ? (const char*)g.Bt + (size_t)nxt.pn * tstepB : cB;
        for (int t = 0; t < nt; t += 2) {
            const bool last = (t == nt - 2);
            const char* a1 = cA + (size_t)(t + 1) * kstep;
            const char* a2 = last ? nA : cA + (size_t)(t + 2) * kstep; const char* b2 = last ? nB : cB + (size_t)(t + 2) * kstep;
            const char* a3 = a2 + kstep; const char* b3 = b2 + kstep;
            PG8_LDB(B0, 0, 0); PG8_SCHED; PG8_LDA(At, 0, 0); PG8_STAGE(PG8_SA(1, 1), a1 + hstepA, voffA);
            PG8_WAIT_L(8); PG8_BAR; PG8_WAIT_L(0); PG8_MMA(0, 0, At, B0); PG8_BAR; PG8_SCHED;
            PG8_LDB(B1, 0, 1); PG8_STAGE(PG8_SB(0, 0), b2, voffB);
            PG8_BAR; PG8_WAIT_L(0); PG8_MMA(0, 1, At, B1); PG8_BAR;
            PG8_LDA(At, 0, 1); PG8_STAGE(PG8_SA(0, 0), a2, voffA);
            PG8_BAR; PG8_WAIT_L(0); PG8_MMA(1, 0, At, B0); PG8_BAR; PG8_SCHED;
            PG8_STAGE(PG8_SB(0, 1), b2 + hstepB, voffB);
            PG8_WAIT_V(6); PG8_BAR; PG8_MMA(1, 1, At, B1); PG8_BAR;
            PG8_LDB(B0, 1, 0); PG8_SCHED; PG8_LDA(At, 1, 0); PG8_STAGE(PG8_SA(0, 1), a2 + hstepA, voffA);
            PG8_WAIT_L(8); PG8_BAR; PG8_WAIT_L(0); PG8_MMA(0, 0, At, B0); PG8_BAR; PG8_SCHED;
            PG8_LDB(B1, 1, 1); PG8_STAGE(PG8_SB(1, 0), b3, voffB);
            PG8_BAR; PG8_WAIT_L(0); PG8_MMA(0, 1, At, B1); PG8_BAR;
            PG8_LDA(At, 1, 1); PG8_STAGE(PG8_SA(1, 0), a3, voffA);
            PG8_BAR; PG8_WAIT_L(0); PG8_MMA(1, 0, At, B0); PG8_BAR; PG8_SCHED;
            PG8_STAGE(PG8_SB(1, 1), b3 + hstepB, voffB);
            PG8_WAIT_V(6); PG8_BAR; PG8_MMA(1, 1, At, B1); PG8_BAR;
        }
        E(acc, cur, wr, wc, fr, fq);
        if (!has_next) break;
#pragma unroll
        for (int a = 0; a < 2; ++a)
#pragma unroll
            for (int b = 0; b < 2; ++b)
#pragma unroll
                for (int m = 0; m < 4; ++m)
#pragma unroll
                    for (int n = 0; n < 2; ++n) acc[a][b][m][n] = (f32x4){0.f, 0.f, 0.f, 0.f};
        cur = nxt; cA = nA; cB = nB; ++ui;
    }
    PG8_WAIT_V(0);
    if (wr == 0) PG8_BAR;
    PG8_BAR;
#undef PG8_SA
#undef PG8_SB
#undef PG8_STAGE
#undef PG8_LDA
#undef PG8_LDB
#undef PG8_MMA
#undef PG8_WAIT_V
#undef PG8_WAIT_L
#undef PG8_BAR
#undef PG8_SCHED
}
}

template <int LNF, int ACT> struct EpiProj {
    static constexpr bool PERM = true;
    bf16_t* O; int ldc; const i64* stats; int ss_idx; const float* csum; const float* bw; i64* ssq;
    __device__ __forceinline__ void operator()(const f32x4 (&acc)[2][2][4][2], const pg8::Unit& u, int wr, int wc, int fr, int fq) const {
        const int row0 = u.pm * 256 + wr * 64 + fr, col0 = u.pn * 256 + wc * 32 + 8 * fq;
        const bool ln = (LNF == 0) && (stats != nullptr);
        typedef long long i64x2 __attribute__((ext_vector_type(2)));
        f32x4 cs[2][2], bv[2][2];
#pragma unroll
        for (int bj = 0; bj < 2; ++bj)
#pragma unroll
            for (int n = 0; n < 2; ++n) {
                cs[bj][n] = ln ? *(const f32x4*)(csum + col0 + bj * 128 + 4 * n) : (f32x4){0.f, 0.f, 0.f, 0.f};
                bv[bj][n] = ln ? *(const f32x4*)(bw + col0 + bj * 128 + 4 * n) : (f32x4){0.f, 0.f, 0.f, 0.f}; }
#pragma unroll
        for (int ai = 0; ai < 2; ++ai) {
            float mu_[4], rs_[4];
#pragma unroll
            for (int i = 0; i < 4; ++i) { const int row = row0 + ai * 128 + i * 16; mu_[i] = 0.f; rs_[i] = 1.f;
                if (LNF == 2 || ln) { const i64x2 sq = *(const i64x2*)(stats + row * 2);
                    if (LNF == 0) { mu_[i] = from_fx(sq[0], 1.f / DM); const float var = from_fx(sq[1], 1.f / DM) - mu_[i] * mu_[i]; rs_[i] = rsqrtf(var + LN_EPS); }
                    else rs_[i] = rsqrtf(from_fx(ss_idx ? sq[1] : sq[0], 1.f / 512.f) + RMS_EPS); } }
#pragma unroll
            for (int m = 0; m < 4; ++m) {
                const int row = row0 + ai * 128 + m * 16;
                const float rs = rs_[m], mu = mu_[m];
                float ssum = 0.f;
                bf16_t* rowp = O + (size_t)row * ldc + col0;
#pragma unroll
                for (int bj = 0; bj < 2; ++bj) {
                    f32x4 v0 = acc[ai][bj][m][0], v1 = acc[ai][bj][m][1];
                    if (LNF == 0) { v0 = rs * (v0 - mu * cs[bj][0]) + bv[bj][0]; v1 = rs * (v1 - mu * cs[bj][1]) + bv[bj][1]; }
                    else { v0 = rs * v0; v1 = rs * v1; }
                    if (ACT == 1) {
#pragma unroll
                        for (int j = 0; j < 4; ++j) { float a = fmaxf(v0[j], 0.f), b = fmaxf(v1[j], 0.f); v0[j] = a * a; v1[j] = b * b; } }
                    if (LNF == 0 && ACT == 0) {
#pragma unroll
                        for (int j = 0; j < 4; ++j) ssum += v0[j] * v0[j] + v1[j] * v1[j]; }
                    u32x4 w; w.x = cvt_pk_bf16(v0[0], v0[1]); w.y = cvt_pk_bf16(v0[2], v0[3]); w.z = cvt_pk_bf16(v1[0], v1[1]); w.w = cvt_pk_bf16(v1[2], v1[3]);
                    *(u32x4*)(rowp + bj * 128) = w; }
                if (LNF == 0 && ACT == 0) { if (ssq != nullptr) {
                    ssum += __shfl_xor(ssum, 16); ssum += __shfl_xor(ssum, 32);
                    if (fq == 0 && u.pn < 4) fx_add(ssq + row * 2 + (u.pn >> 1), ssum); } }
            }
        }
    }
};
struct EpiRes {
    static constexpr bool PERM = true;
    const float* src; float* Y; bf16_t* YB; const i64* stats_prev; const float* g; const float* b; i64* stats_new;
    __device__ __forceinline__ void operator()(const f32x4 (&acc)[2][2][4][2], const pg8::Unit& u, int wr, int wc, int fr, int fq) const {
        const int row0 = u.pm * 256 + wr * 64 + fr, col0 = u.pn * 256 + wc * 32 + 8 * fq;
        const bool ln = stats_prev != nullptr;
        typedef long long i64x2 __attribute__((ext_vector_type(2)));
        const float* __restrict__ srcr = src; float* __restrict__ Yr = Y; bf16_t* __restrict__ YBr = YB; const i64* __restrict__ spr = stats_prev;
        f32x4 gv[2][2], bv[2][2];
#pragma unroll
        for (int bj = 0; bj < 2; ++bj)
#pragma unroll
            for (int n = 0; n < 2; ++n) {
                gv[bj][n] = ln ? *(const f32x4*)(g + col0 + bj * 128 + 4 * n) : (f32x4){1.f, 1.f, 1.f, 1.f};
                bv[bj][n] = ln ? *(const f32x4*)(b + col0 + bj * 128 + 4 * n) : (f32x4){0.f, 0.f, 0.f, 0.f}; }
#pragma unroll
        for (int ai = 0; ai < 2; ++ai) {
            float mu_[4], rs_[4];
#pragma unroll
            for (int i = 0; i < 4; ++i) { const int row = row0 + ai * 128 + i * 16; mu_[i] = 0.f; rs_[i] = 1.f;
                if (ln) { const i64x2 sq = *(const i64x2*)(spr + row * 2);
                    mu_[i] = from_fx(sq[0], 1.f / DM); const float var = from_fx(sq[1], 1.f / DM) - mu_[i] * mu_[i]; rs_[i] = rsqrtf(var + LN_EPS); } }
#pragma unroll
            for (int m = 0; m < 4; ++m) {
                const int row = row0 + ai * 128 + m * 16;
                const float rs = rs_[m], mu = mu_[m];
                float s1 = 0.f, s2 = 0.f;
                const size_t ro = (size_t)row * DM + col0;
#pragma unroll
                for (int bj = 0; bj < 2; ++bj) {
                    const f32x4 p0 = *(const f32x4*)(srcr + ro + bj * 128), p1 = *(const f32x4*)(srcr + ro + bj * 128 + 4);
                    const f32x4 h0 = (p0 - mu) * rs * gv[bj][0] + bv[bj][0], h1 = (p1 - mu) * rs * gv[bj][1] + bv[bj][1];
                    const f32x4 y0 = ALPHA * h0 + acc[ai][bj][m][0], y1 = ALPHA * h1 + acc[ai][bj][m][1];
                    *(f32x4*)(Yr + ro + bj * 128) = y0; *(f32x4*)(Yr + ro + bj * 128 + 4) = y1;
#pragma unroll
                    for (int j = 0; j < 4; ++j) { s1 += y0[j] + y1[j]; s2 += y0[j] * y0[j] + y1[j] * y1[j]; }
                    u32x4 w; w.x = cvt_pk_bf16(y0[0], y0[1]); w.y = cvt_pk_bf16(y0[2], y0[3]); w.z = cvt_pk_bf16(y1[0], y1[1]); w.w = cvt_pk_bf16(y1[2], y1[3]);
                    *(u32x4*)(YBr + ro + bj * 128) = w; }
                s1 += __shfl_xor(s1, 16); s1 += __shfl_xor(s1, 32); s2 += __shfl_xor(s2, 16); s2 += __shfl_xor(s2, 32);
                if (fq == 0) { fx_add(stats_new + row * 2, s1); fx_add(stats_new + row * 2 + 1, s2); }
            }
        }
    }
};

__device__ __forceinline__ void prep_item(LAS unsigned char* lds, const WDesc& d, int item) {
    const int tid = ltid(), kp = tid >> 4, cc = tid & 15;
    const int nkc = d.K / d.kchunk, strip = item / nkc, kc = item % nkc;
    const int n0 = strip * 128, k0 = kc * d.kchunk, k1 = k0 + d.kchunk, N = d.N, K = d.K;
    const bool inr = (n0 + cc * 8) < N;
    const bool docs = d.csum != nullptr;
    float cs[8], bs[8];
#pragma unroll
    for (int j = 0; j < 8; ++j) { cs[j] = 0.f; bs[j] = 0.f; }
    int buf = 0;
    f32x4 na0 = {0.f, 0.f, 0.f, 0.f}, na1 = na0, nb0 = na0, nb1 = na0; float ng0 = 1.f, ng1 = 1.f, ne0 = 0.f, ne1 = 0.f;
#define PREP_LOAD(kt_) do { const int ka_ = (kt_) + 2 * kp; \
        if (inr) { const float* p0 = d.W + (size_t)ka_ * N + n0 + cc * 8; na0 = *(const f32x4*)p0; na1 = *(const f32x4*)(p0 + 4); nb0 = *(const f32x4*)(p0 + N); nb1 = *(const f32x4*)(p0 + N + 4); } \
        if (d.g) { ng0 = d.g[ka_]; ng1 = d.g[ka_ + 1]; } if (d.bvec) { ne0 = d.bvec[ka_]; ne1 = d.bvec[ka_ + 1]; } } while (0)
    PREP_LOAD(k0);
    for (int kt = k0; kt < k1; kt += 64) {
        const f32x4 a0 = na0, a1 = na1, b0 = nb0, b1 = nb1; const float g0 = ng0, g1 = ng1, e0 = ne0, e1 = ne1;
        if (kt + 64 < k1) PREP_LOAD(kt + 64);
        LAS unsigned* Tb = (LAS unsigned*)(lds + buf * 16896);
#pragma unroll
        for (int j = 0; j < 8; ++j) {
            const float x0 = j < 4 ? a0[j & 3] : a1[j & 3], x1 = j < 4 ? b0[j & 3] : b1[j & 3];
            const unsigned pk = cvt_pk_bf16(x0 * g0, x1 * g1);
            if (docs) { cs[j] += bf_lo(pk) + bf_hi(pk); bs[j] += e0 * x0 + e1 * x1; }
            Tb[(cc * 8 + j) * 33 + kp] = pk; }
        __syncthreads();
#pragma unroll
        for (int i = 0; i < 2; ++i) { const int id = tid + 512 * i, n = id >> 3, ch = id & 7;
            u32x4 v; v.x = Tb[n * 33 + ch * 4]; v.y = Tb[n * 33 + ch * 4 + 1]; v.z = Tb[n * 33 + ch * 4 + 2]; v.w = Tb[n * 33 + ch * 4 + 3];
            *(u32x4*)(d.WT + (size_t)(n0 + n) * K + kt + ch * 8) = v; }
        buf ^= 1;
    }
#undef PREP_LOAD
    if (docs) {
        LAS float* red = (LAS float*)(lds + 34816);
#pragma unroll
        for (int j = 0; j < 8; ++j) { red[kp * 128 + cc * 8 + j] = cs[j]; red[4096 + kp * 128 + cc * 8 + j] = bs[j]; }
        __syncthreads();
        if (tid < 256) { const int which = tid >> 7, n = tid & 127; float s = 0.f;
            for (int k = 0; k < 32; ++k) s += red[which * 4096 + k * 128 + n];
            (which ? d.bw : d.csum)[n0 + n] = s; }
    }
    __syncthreads();
}

__device__ __attribute__((noinline)) void rope_entry(float* rt, int i) {
          const int pos = i >> 5, fi = i & 31;
          double inv = 1.0; for (int k = 0; k < fi; ++k) inv *= 0.7498942093324559;
          const double ang = (double)pos * inv;
          const double n2 = __builtin_rint(ang * 0.15915494309189535);
          double r = ang - n2 * 6.283185307179586;
          const double kq = __builtin_rint(r * 0.6366197723675814);
          const double t = r - kq * 1.5707963267948966;
          const double t2 = t * t;
          const double s = t * (1.0 + t2 * (-1.0 / 6 + t2 * (1.0 / 120 + t2 * (-1.0 / 5040 + t2 * (1.0 / 362880 + t2 * (-1.0 / 39916800 + t2 * (1.0 / 6227020800.0)))))));
          const double c = 1.0 + t2 * (-0.5 + t2 * (1.0 / 24 + t2 * (-1.0 / 720 + t2 * (1.0 / 40320 + t2 * (-1.0 / 3628800 + t2 * (1.0 / 479001600.0))))));
          const int q = ((int)kq) & 3;
          const double sn = q == 0 ? s : (q == 1 ? c : (q == 2 ? -s : -c));
          const double cn = q == 0 ? c : (q == 1 ? -s : (q == 2 ? -c : s));
          rt[i] = (float)cn; rt[SEQ * 32 + i] = (float)sn;
}
__device__ __forceinline__ void phase_prep(LAS unsigned char* lds, const Params& p) {
    const int tid = ltid();
    const int gtid = lbid() * 512 + tid, gsz = lgdim() * 512;
    { i64* st = (i64*)(p.ws + OFF_STATS); for (int i = gtid; i < ST_TOTAL; i += gsz) st[i] = 0; }
    { float* rt = (float*)(p.ws + OFF_ROPE);
      for (int i = gtid; i < SEQ * 32; i += gsz) rope_entry(rt, i); }
    { const f32x4* x4 = (const f32x4*)p.in[0]; u32x2* yb = (u32x2*)(p.ws + OFF_YB);
      for (int i = gtid; i < T_ * DM / 4; i += gsz) { const f32x4 v = x4[i]; u32x2 o; o.x = cvt_pk_bf16(v[0], v[1]); o.y = cvt_pk_bf16(v[2], v[3]); yb[i] = o; } }
    for (int it = lbid(); it < p.total_items; it += lgdim()) {
        int di = 0;
        for (int k = 1; k < p.nwd; ++k) if (it >= p.wd[k].item0) di = k;
        prep_item(lds, p.wd[di], it - p.wd[di].item0);
    }
}

__device__ __forceinline__ int crow(int r, int hi) { return (r & 3) + 8 * (r >> 2) + 4 * hi; }
__device__ __forceinline__ float xhalf_(float v, int hi) { const auto rr = __builtin_amdgcn_permlane32_swap(__float_as_uint(v), __float_as_uint(v), false, false); return __uint_as_float(hi ? rr[0] : rr[1]); }
#define xhalf(v) xhalf_((v), hi)
#define MFMA32(a, b, c) __builtin_amdgcn_mfma_f32_32x32x16_bf16((a), (b), (c), 0, 0, 0)

#define DS_RD128(dst, addr, OFF) asm volatile("ds_read_b128 %0, %1 offset:%2" : "=v"(dst) : "v"(addr), "n"(OFF))
#define DS_RDTR(dst, addr, OFF)  asm volatile("ds_read_b64_tr_b16 %0, %1 offset:%2" : "=v"(dst) : "v"(addr), "n"(OFF))
#define LGKM_WAIT4(N, a, b, c, d) asm volatile("s_waitcnt lgkmcnt(" #N ")" : "+v"(a), "+v"(b), "+v"(c), "+v"(d))
#define LGKM_WAIT6(N, a, b, c, d, e, f) asm volatile("s_waitcnt lgkmcnt(" #N ")" : "+v"(a), "+v"(b), "+v"(c), "+v"(d), "+v"(e), "+v"(f))
#define LGKM_WAIT8(N, a, b, c, d, e, f, g, h) asm volatile("s_waitcnt lgkmcnt(" #N ")" : "+v"(a), "+v"(b), "+v"(c), "+v"(d), "+v"(e), "+v"(f), "+v"(g), "+v"(h))
#define SKEW_SLEEP 10
template <int V> struct IC { static constexpr int value = V; };
struct AttnArgs { const bf16_t* q; const bf16_t* kv; const bf16_t* kr; const float* rope; const float* bias; bf16_t* o; };

template <int MODE>
__device__ __forceinline__ void attn_phase(LAS unsigned char* lds, const AttnArgs& a) {
    constexpr int DQK = MODE == 0 ? 192 : 128, ND0 = DQK / 16, KSTR = 272, VSTR = 288, RSTR = 144;
    constexpr int KOFF = 0, VOFF = 64 * KSTR, ROFF = VOFF + 64 * VSTR, BUF = ROFF + (MODE == 0 ? 64 * RSTR : 0);
    constexpr int NI_K = 17, NI_V = 18, NI_R = MODE == 0 ? 9 : 0, NI = NI_K + NI_V + NI_R, NPW = (NI + 7) / 8;
    constexpr int LDQ = MODE == 0 ? 3072 : 6144, LDKV = MODE == 0 ? 4096 : 6144;
    constexpr float SC = MODE == 0 ? 0.07216878364870322f : 0.08838834764831845f;
    constexpr float C2 = SC * LOG2E;
    int tid = threadIdx.x; asm volatile("" : "+v"(tid));
    const int wid = __builtin_amdgcn_readfirstlane(tid >> 6), lane = tid & 63, r32 = lane & 31, hi = lane >> 5;
    const int i16 = lane & 15, q4 = i16 >> 2, p4 = i16 & 3, blk = (lane >> 4) & 1;
    LAS float* tb = (LAS float*)(lds + 2 * BUF);
    constexpr int QR_OFF = 2 * BUF + 768, NQR = ND0;
    unsigned voff[NPW];
#pragma unroll
    for (int i = 0; i < NPW; ++i) { const int j = wid + 8 * i;
        if (j < NI_K) { const int c = j * 64 + lane, row = c / 17, cc = c % 17; voff[i] = (unsigned)(row * (LDKV * 2) + (cc < 16 ? cc * 16 : 0)); }
        else if (j < NI_K + NI_V) { const int c = (j - NI_K) * 64 + lane, row = c / 18, cc = c % 18; voff[i] = (unsigned)(row * (LDKV * 2) + (cc < 16 ? cc * 16 : 0)); }
        else { const int c = (j - NI_K - NI_V) * 64 + lane, row = c / 9, cc = c % 9; voff[i] = (unsigned)(row * 128 + (cc < 8 ? cc * 16 : 0)); } }
    for (int bid_ = lbid(); bid_ < 256; bid_ += lgdim()) {
        const int it = bid_;
        const int bh = it >> 2, gp = it & 3, b = bh >> 4, h = bh & 15, tok0 = b * SEQ;
        for (int half = 0; half < 2; ++half) {
            const int g = half ? 7 - gp : gp;
            const int q0 = g * 256 + wid * 32, cw = q0 >> 6, qin = (q0 & 63) + r32;
            const char* kbase = (const char*)(MODE == 0 ? a.kv + h * 256 : a.q + 2048 + h * 128) + (size_t)tok0 * (LDKV * 2);
            const char* vbase_g = kbase + (MODE == 0 ? 256 : 4096);
            const char* rbase = (const char*)a.kr + (size_t)tok0 * 128;
#define ST_ISSUE(kc, bufi) do { _Pragma("unroll") for (int i_ = 0; i_ < NPW; ++i_) { const int j_ = wid + 8 * i_; if (j_ < NI) { \
    const char* src_; int dst_; \
    if (j_ < NI_K) { src_ = kbase + (size_t)(kc) * (64 * LDKV * 2); dst_ = KOFF + j_ * 1024; } \
    else if (j_ < NI_K + NI_V) { src_ = vbase_g + (size_t)(kc) * (64 * LDKV * 2); dst_ = VOFF + (j_ - NI_K) * 1024; } \
    else { src_ = rbase + (size_t)(kc) * (64 * 128); dst_ = ROFF + (j_ - NI_K - NI_V) * 1024; } \
    __builtin_amdgcn_global_load_lds((const unsigned*)(src_ + voff[i_]), (LAS unsigned*)(lds + (bufi) * BUF + dst_), 16, 0, 0); } } } while (0)
            const int kc_lo = MODE == 2 ? (4 * g - 8 > 0 ? 4 * g - 8 : 0) : 0, kc_hi = 4 * g + 3, nt = kc_hi - kc_lo + 1;
            ST_ISSUE((MODE == 1 ? kc_hi : kc_lo), 0);
            bf16x8 qr[ND0];
            { int ln = lane; asm volatile("" : "+v"(ln)); const int r32q = ln & 31, hiq = ln >> 5;
              const bf16_t* qp = a.q + (size_t)(tok0 + q0 + r32q) * LDQ + (MODE == 0 ? h * 192 : h * 128) + hiq * 8;
#pragma unroll
              for (int d0 = 0; d0 < ND0; ++d0) qr[d0] = *(const bf16x8*)(qp + d0 * 16);
              if (MODE == 0) {
                  const float* ct = a.rope + (size_t)(q0 + r32q) * 32 + hiq * 8; const float* st = ct + SEQ * 32;
#pragma unroll
                  for (int e = 0; e < 2; ++e) {
                      const f32x4 c0 = *(const f32x4*)(ct + e * 16), c1 = *(const f32x4*)(ct + e * 16 + 4), s0 = *(const f32x4*)(st + e * 16), s1 = *(const f32x4*)(st + e * 16 + 4);
                      const u32x4 x1 = __builtin_bit_cast(u32x4, qr[8 + e]), x2 = __builtin_bit_cast(u32x4, qr[10 + e]);
                      u32x4 o1, o2;
#pragma unroll
                      for (int w = 0; w < 4; ++w) {
                          const float ca = w < 2 ? c0[2 * w] : c1[2 * w - 4], cb = w < 2 ? c0[2 * w + 1] : c1[2 * w - 3];
                          const float sa = w < 2 ? s0[2 * w] : s1[2 * w - 4], sb = w < 2 ? s0[2 * w + 1] : s1[2 * w - 3];
                          const float a1 = bf_lo(x1[w]), b1 = bf_hi(x1[w]), a2 = bf_lo(x2[w]), b2 = bf_hi(x2[w]);
                          o1[w] = cvt_pk_bf16(a1 * ca - a2 * sa, b1 * cb - b2 * sb);
                          o2[w] = cvt_pk_bf16(a2 * ca + a1 * sa, b2 * cb + b1 * sb); }
                      qr[8 + e] = __builtin_bit_cast(bf16x8, o1); qr[10 + e] = __builtin_bit_cast(bf16x8, o2); } } }
            if (MODE == 0) {
#pragma unroll
                for (int f = 0; f < ND0 - NQR; ++f) *(LAS bf16x8*)(lds + QR_OFF + f * 8192 + tid * 16) = qr[NQR + f];
            }
            if (MODE == 2) { if (tid < 192) tb[tid] = a.bias[tid * 16 + h] * LOG2E; }
            f32x16 od[4];
#pragma unroll
            for (int d = 0; d < 4; ++d)
#pragma unroll
                for (int r = 0; r < 16; ++r) od[d][r] = 0.f;
            float m_run = -1e30f, l_run = 0.f, carry = 0.f;
            asm volatile("s_waitcnt vmcnt(0)" ::: "memory");
            __syncthreads();
            auto tile_step = [&](auto CURC, const int i) __attribute__((always_inline)) -> bool {
                constexpr int CUR = decltype(CURC)::value;
                const int kc = MODE == 1 ? kc_hi - i : kc_lo + i;
                if (i + 1 < nt) ST_ISSUE((MODE == 1 ? kc - 1 : kc + 1), (1 - CUR));
                const bool active = MODE == 2 ? (kc <= cw && kc >= cw - 8) : (kc <= cw);
                if (active) {
                    if (((wid >> 2) & 1) != 0) __builtin_amdgcn_s_sleep(SKEW_SLEEP);
                    LAS unsigned char* Kb = lds + CUR * BUF;
                    f32x16 p0, p1;
#pragma unroll
                    for (int r = 0; r < 16; ++r) { p0[r] = 0.f; p1[r] = 0.f; }
                    {
                        const unsigned ka = (unsigned)(size_t)(Kb + KOFF + r32 * KSTR + hi * 16), ra = (unsigned)(size_t)(Kb + ROFF + r32 * RSTR + hi * 16);
                        const unsigned pa = (unsigned)(size_t)(lds + QR_OFF + tid * 16);
                        bf16x8 kA0, kA1, kA2, kA3, kB0, kB1, kB2, kB3, qA0, qA1, qB0, qB1;
#define QK_LD(k0_, k1_, k2_, k3_, q0_, q1_, PJ) do { \
    if ((PJ) < 4) { DS_RD128(k0_, ka, (2 * (PJ)) * 32); DS_RD128(k1_, ka, (2 * (PJ)) * 32 + 32 * KSTR); DS_RD128(k2_, ka, (2 * (PJ) + 1) * 32); DS_RD128(k3_, ka, (2 * (PJ) + 1) * 32 + 32 * KSTR); } \
    else { DS_RD128(k0_, ra, (2 * ((PJ) & 3)) * 32); DS_RD128(k1_, ra, (2 * ((PJ) & 3)) * 32 + 32 * RSTR); DS_RD128(k2_, ra, (2 * ((PJ) & 3) + 1) * 32); DS_RD128(k3_, ra, (2 * ((PJ) & 3) + 1) * 32 + 32 * RSTR); \
           } } while (0)
#define QK_MM(k0_, k1_, k2_, k3_, q0_, q1_, PJ) do { \
    const bf16x8 qa_ = qr[(2 * (PJ)) < ND0 ? 2 * (PJ) : 0], qb_ = qr[(2 * (PJ) + 1) < ND0 ? 2 * (PJ) + 1 : 0]; \
    p0 = MFMA32(k0_, qa_, p0); p1 = MFMA32(k1_, qa_, p1); p0 = MFMA32(k2_, qb_, p0); p1 = MFMA32(k3_, qb_, p1); } while (0)
                        QK_LD(kA0, kA1, kA2, kA3, qA0, qA1, 0);
                        QK_LD(kB0, kB1, kB2, kB3, qB0, qB1, 1);
                        LGKM_WAIT4(4, kA0, kA1, kA2, kA3); __builtin_amdgcn_sched_barrier(0);
                        QK_MM(kA0, kA1, kA2, kA3, qA0, qA1, 0); __builtin_amdgcn_sched_barrier(0);
                        QK_LD(kA0, kA1, kA2, kA3, qA0, qA1, 2);
                        LGKM_WAIT4(4, kB0, kB1, kB2, kB3); __builtin_amdgcn_sched_barrier(0);
                        QK_MM(kB0, kB1, kB2, kB3, qB0, qB1, 1); __builtin_amdgcn_sched_barrier(0);
                        QK_LD(kB0, kB1, kB2, kB3, qB0, qB1, 3);
                        LGKM_WAIT4(4, kA0, kA1, kA2, kA3); __builtin_amdgcn_sched_barrier(0);
                        QK_MM(kA0, kA1, kA2, kA3, qA0, qA1, 2); __builtin_amdgcn_sched_barrier(0);
                        if (MODE == 0) {
                            QK_LD(kA0, kA1, kA2, kA3, qA0, qA1, 4);
                            LGKM_WAIT4(4, kB0, kB1, kB2, kB3); __builtin_amdgcn_sched_barrier(0);
                            QK_MM(kB0, kB1, kB2, kB3, qB0, qB1, 3); __builtin_amdgcn_sched_barrier(0);
                            QK_LD(kB0, kB1, kB2, kB3, qB0, qB1, 5);
                            LGKM_WAIT4(4, kA0, kA1, kA2, kA3); __builtin_amdgcn_sched_barrier(0);
                            QK_MM(kA0, kA1, kA2, kA3, qA0, qA1, 4); __builtin_amdgcn_sched_barrier(0);
                            LGKM_WAIT4(0, kB0, kB1, kB2, kB3); __builtin_amdgcn_sched_barrier(0);
                            QK_MM(kB0, kB1, kB2, kB3, qB0, qB1, 5); __builtin_amdgcn_sched_barrier(0);
                        } else {
                            LGKM_WAIT4(0, kB0, kB1, kB2, kB3); __builtin_amdgcn_sched_barrier(0);
                            QK_MM(kB0, kB1, kB2, kB3, qB0, qB1, 3); __builtin_amdgcn_sched_barrier(0);
                        }
#undef QK_LD
#undef QK_MM
                    }
                    if (MODE == 1) {
                        const bool diag = kc == cw;
#pragma unroll
                        for (int sub = 1; sub >= 0; --sub) {
                            f32x16& p = sub ? p1 : p0;
                            float l1[16], G[4], PG[4];
#pragma unroll
                            for (int r = 0; r < 16; ++r) {
                                const float z = p[r] * C2, e = __builtin_amdgcn_exp2f(-fabsf(z)), L = __builtin_amdgcn_logf(1.f + e);
                                float lb = fminf(z, 0.f) - L, lm = fminf(-z, 0.f) - L;
                                if (diag) { const bool valid = (sub * 32 + crow(r, hi)) < qin; lb = valid ? lb : -1e30f; lm = valid ? lm : 0.f; }
                                p[r] = lb; l1[r] = lm; }
#pragma unroll
                            for (int gi = 0; gi < 4; ++gi) { G[gi] = (l1[4 * gi] + l1[4 * gi + 1]) + (l1[4 * gi + 2] + l1[4 * gi + 3]); PG[gi] = xhalf(G[gi]); }
                            float run = carry;
#pragma unroll
                            for (int gi = 3; gi >= 0; --gi) {
                                const float s3 = hi ? run : run + PG[gi];
                                const float s2 = s3 + l1[4 * gi + 3], s1 = s2 + l1[4 * gi + 2], s0 = s1 + l1[4 * gi + 1];
                                p[4 * gi + 3] = __builtin_amdgcn_exp2f(p[4 * gi + 3] + s3); p[4 * gi + 2] = __builtin_amdgcn_exp2f(p[4 * gi + 2] + s2);
                                p[4 * gi + 1] = __builtin_amdgcn_exp2f(p[4 * gi + 1] + s1); p[4 * gi] = __builtin_amdgcn_exp2f(p[4 * gi] + s0);
                                run += G[gi] + PG[gi]; }
                            carry = run; }
                    } else {
                        if (MODE == 2) {
                            if (kc >= cw - 2) {
                                const int rel0 = kc * 64 - (q0 + r32);
#pragma unroll
                                for (int r = 0; r < 16; ++r) {
                                    int i0 = rel0 + crow(r, hi), i1 = i0 + 32;
                                    i0 = (i0 < -128 ? -128 : (i0 > 63 ? 63 : i0)) + 128; i1 = (i1 < -128 ? -128 : (i1 > 63 ? 63 : i1)) + 128;
                                    p0[r] = p0[r] * C2 + tb[i0]; p1[r] = p1[r] * C2 + tb[i1]; }
                            } else { const float b0 = tb[0];
#pragma unroll
                                for (int r = 0; r < 16; ++r) { p0[r] = p0[r] * C2 + b0; p1[r] = p1[r] * C2 + b0; } }
                        } else {
#pragma unroll
                            for (int r = 0; r < 16; ++r) { p0[r] *= C2; p1[r] *= C2; }
                        }
                        float mx = p0[0];
#pragma unroll
                        for (int r = 1; r < 16; ++r) mx = fmaxf(mx, p0[r]);
#pragma unroll
                        for (int r = 0; r < 16; ++r) mx = fmaxf(mx, p1[r]);
                        mx = fmaxf(mx, xhalf(mx));
                        const float mn = fmaxf(m_run, mx), al = __builtin_amdgcn_exp2f(m_run - mn);
                        m_run = mn;
                        float ps = 0.f;
#pragma unroll
                        for (int r = 0; r < 16; ++r) { p0[r] = __builtin_amdgcn_exp2f(p0[r] - mn); p1[r] = __builtin_amdgcn_exp2f(p1[r] - mn); ps += p0[r] + p1[r]; }
                        ps += xhalf(ps);
                        l_run = l_run * al + ps;
                        if (__any(al != 1.f)) {
#pragma unroll
                            for (int d = 0; d < 4; ++d)
#pragma unroll
                                for (int r = 0; r < 16; ++r) od[d][r] *= al; }
                    }
                    bf16x8 pb[4];
#pragma unroll
                    for (int s = 0; s < 4; ++s) { const f32x16& p = s < 2 ? p0 : p1; const int o = (s & 1) * 8;
                        u32x4 w; w.x = cvt_pk_bf16(p[o], p[o + 1]); w.y = cvt_pk_bf16(p[o + 2], p[o + 3]); w.z = cvt_pk_bf16(p[o + 4], p[o + 5]); w.w = cvt_pk_bf16(p[o + 6], p[o + 7]);
                        pb[s] = __builtin_bit_cast(bf16x8, w); }
                    LAS unsigned char* vbase = Kb + VOFF + (4 * hi + q4) * VSTR + blk * 32 + p4 * 8;
                    {
                        const unsigned va = (unsigned)(size_t)vbase;
                        s16x4 lA0, lA1, lA2, lA3, hA0, hA1, hA2, hA3, lB0, lB1, lB2, lB3, hB0, hB1, hB2, hB3;
#define PV_LD(l0, l1, l2, l3, h0, h1, h2, h3, D_) do { \
    DS_RDTR(l0, va, 0 * 16 * VSTR + (D_) * 64); DS_RDTR(h0, va, (0 * 16 + 8) * VSTR + (D_) * 64); DS_RDTR(l1, va, 1 * 16 * VSTR + (D_) * 64); DS_RDTR(h1, va, (1 * 16 + 8) * VSTR + (D_) * 64); \
    DS_RDTR(l2, va, 2 * 16 * VSTR + (D_) * 64); DS_RDTR(h2, va, (2 * 16 + 8) * VSTR + (D_) * 64); DS_RDTR(l3, va, 3 * 16 * VSTR + (D_) * 64); DS_RDTR(h3, va, (3 * 16 + 8) * VSTR + (D_) * 64); } while (0)
#define PV_MM(l0, l1, l2, l3, h0, h1, h2, h3, D_) do { \
    od[D_] = MFMA32(__builtin_shufflevector(l0, h0, 0, 1, 2, 3, 4, 5, 6, 7), pb[0], od[D_]); od[D_] = MFMA32(__builtin_shufflevector(l1, h1, 0, 1, 2, 3, 4, 5, 6, 7), pb[1], od[D_]); \
    od[D_] = MFMA32(__builtin_shufflevector(l2, h2, 0, 1, 2, 3, 4, 5, 6, 7), pb[2], od[D_]); od[D_] = MFMA32(__builtin_shufflevector(l3, h3, 0, 1, 2, 3, 4, 5, 6, 7), pb[3], od[D_]); } while (0)
                        PV_LD(lA0, lA1, lA2, lA3, hA0, hA1, hA2, hA3, 0);
                        PV_LD(lB0, lB1, lB2, lB3, hB0, hB1, hB2, hB3, 1);
                        LGKM_WAIT8(8, lA0, lA1, lA2, lA3, hA0, hA1, hA2, hA3); __builtin_amdgcn_sched_barrier(0);
                        PV_MM(lA0, lA1, lA2, lA3, hA0, hA1, hA2, hA3, 0); __builtin_amdgcn_sched_barrier(0);
                        PV_LD(lA0, lA1, lA2, lA3, hA0, hA1, hA2, hA3, 2);
                        LGKM_WAIT8(8, lB0, lB1, lB2, lB3, hB0, hB1, hB2, hB3); __builtin_amdgcn_sched_barrier(0);
                        PV_MM(lB0, lB1, lB2, lB3, hB0, hB1, hB2, hB3, 1); __builtin_amdgcn_sched_barrier(0);
                        PV_LD(lB0, lB1, lB2, lB3, hB0, hB1, hB2, hB3, 3);
                        LGKM_WAIT8(8, lA0, lA1, lA2, lA3, hA0, hA1, hA2, hA3); __builtin_amdgcn_sched_barrier(0);
                        PV_MM(lA0, lA1, lA2, lA3, hA0, hA1, hA2, hA3, 2); __builtin_amdgcn_sched_barrier(0);
                        LGKM_WAIT8(0, lB0, lB1, lB2, lB3, hB0, hB1, hB2, hB3); __builtin_amdgcn_sched_barrier(0);
                        PV_MM(lB0, lB1, lB2, lB3, hB0, hB1, hB2, hB3, 3); __builtin_amdgcn_sched_barrier(0);
#undef PV_LD
#undef PV_MM
                    }
                }
                asm volatile("s_waitcnt vmcnt(0)" ::: "memory");
                if (MODE == 1) {
                    if (__syncthreads_and((kc <= cw) && (carry <= -160.f))) return true;
                } else __syncthreads();
                return false;
            };
            for (int i = 0; i < nt; i += 2) {
                if (tile_step(IC<0>{}, i)) break;
                if (i + 1 < nt) { if (tile_step(IC<1>{}, i + 1)) break; }
            }
#undef ST_ISSUE
            const float inv = MODE == 1 ? 1.f : 1.f / l_run;
            int lo_ = lane; asm volatile("" : "+v"(lo_));
            bf16_t* op = a.o + (size_t)(tok0 + q0 + (lo_ & 31)) * DM + h * 128 + 4 * (lo_ >> 5);
#pragma unroll
            for (int d = 0; d < 4; ++d)
#pragma unroll
                for (int gq = 0; gq < 4; ++gq) {
                    u32x2 w; w.x = cvt_pk_bf16(od[d][4 * gq] * inv, od[d][4 * gq + 1] * inv); w.y = cvt_pk_bf16(od[d][4 * gq + 2] * inv, od[d][4 * gq + 3] * inv);
                    *(u32x2*)(op + d * 32 + 8 * gq) = w; }
            if (MODE == 1) __syncthreads();
        }
    }
}

__device__ __forceinline__ void krope_phase(const bf16_t* down, const float* rope, bf16_t* kr) {
    const size_t gtid = (size_t)lbid() * 512 + ltid(), gsz = (size_t)lgdim() * 512;
    for (size_t i = gtid; i < (size_t)T_ * 32; i += gsz) {
        const int t = (int)(i >> 5), fi = (int)(i & 31), pos = t & (SEQ - 1);
        const float c = rope[pos * 32 + fi], s = rope[SEQ * 32 + pos * 32 + fi];
        const float x1 = __uint_as_float((unsigned)down[(size_t)t * 1280 + 1024 + fi] << 16), x2 = __uint_as_float((unsigned)down[(size_t)t * 1280 + 1056 + fi] << 16);
        const unsigned o = cvt_pk_bf16(x1 * c - x2 * s, x2 * c + x1 * s);
        kr[(size_t)t * 64 + fi] = (bf16_t)(o & 0xffff); kr[(size_t)t * 64 + 32 + fi] = (bf16_t)(o >> 16); }
}

__device__ __forceinline__ void final_ln(const float* Y, const i64* stats, const float* g, const float* b, float* out) {
    const size_t gtid = (size_t)lbid() * 512 + ltid(), gsz = (size_t)lgdim() * 512;
    for (size_t i = gtid; i < (size_t)T_ * DM / 4; i += gsz) {
        const int row = (int)(i >> 9), c4 = (int)(i & 511);
        const float mu = from_fx(stats[row * 2], 1.f / DM), var = from_fx(stats[row * 2 + 1], 1.f / DM) - mu * mu, rs = rsqrtf(var + LN_EPS);
        const f32x4 v = ((const f32x4*)Y)[i], gg = ((const f32x4*)g)[c4], bb = ((const f32x4*)b)[c4];
        ((f32x4*)out)[i] = (v - mu) * rs * gg + bb; }
}


#define XB_TMO      128
#define XB_XCNT(j)  (256  + 64 * (j))
#define XB_XSUB(j)  (1280 + 64 * (j))
#define XB_XGEN(j)  (2304 + 64 * (j))
#define XB_TOP      3328
#define XB_TOPGEN   3392
#define XCD_BAR_WORDS 3456
#define XB_SPIN_CAP (1u << 18)
__device__ __forceinline__ unsigned xb_ld(unsigned* p)              { return __hip_atomic_load(p, __ATOMIC_RELAXED, __HIP_MEMORY_SCOPE_AGENT); }
__device__ __forceinline__ unsigned xb_add(unsigned* p, unsigned v) { return __hip_atomic_fetch_add(p, v, __ATOMIC_RELAXED, __HIP_MEMORY_SCOPE_AGENT); }
__device__ __forceinline__ unsigned xb_xcc_id() { return (unsigned)__builtin_amdgcn_s_getreg((3 << 11) | 20) & 0xFu; }
#define XB_SPIN(cond, bar) do { unsigned _sp = 0; while (cond) { __builtin_amdgcn_s_sleep(1); \
    if ((++_sp & 255u) == 0u) { if (xb_ld(&(bar)[XB_TMO])) break; if (_sp > XB_SPIN_CAP) { atomicAdd(&(bar)[XB_TMO], 1u); break; } } } } while (0)
__device__ __forceinline__ void xcd_barrier_complete(unsigned* bar, unsigned x, unsigned& nloc, unsigned& nx) {
    const unsigned G = gridDim.x;
    unsigned sum, cnt, mine, sp = 0u;
    for (;;) {
        sum = 0u; cnt = 0u; mine = 0u;
#pragma unroll
        for (unsigned j = 0; j < 16; ++j) { const unsigned c = xb_ld(&bar[XB_XCNT(j)]); sum += c; cnt += (c > 0u) ? 1u : 0u; mine = (j == x) ? c : mine; }
        if (sum == G) break;
        __builtin_amdgcn_s_sleep(1);
        if ((++sp & 255u) == 0u) { if (xb_ld(&bar[XB_TMO])) break; if (sp > XB_SPIN_CAP) { atomicAdd(&bar[XB_TMO], 1u); break; } }
    }
    nloc = mine > 0u ? mine : 1u; nx = cnt > 0u ? cnt : 1u;
}
__device__ __forceinline__ void xcd_barrier(unsigned* bar, volatile LAS unsigned* st) {
    asm volatile("s_waitcnt vmcnt(0)" ::: "memory");
    __syncthreads();
    if (threadIdx.x == 0) {
        const unsigned x = xb_xcc_id();
        __builtin_amdgcn_s_waitcnt(0);
        unsigned nloc = st[0], nx = st[1];
        if (nloc == 0u) { xcd_barrier_complete(bar, x, nloc, nx); st[0] = nloc; st[1] = nx; }
        const unsigned old = xb_add(&bar[XB_XSUB(x)], 1u);
        const unsigned gen = old / nloc;
        if (old + 1u == (gen + 1u) * nloc) {
            __builtin_amdgcn_fence(__ATOMIC_RELEASE, "agent");
            asm volatile("s_waitcnt vmcnt(0)" ::: "memory");
            const unsigned og = xb_add(&bar[XB_TOP], 1u);
            const unsigned tg = og / nx;
            if (og + 1u == (tg + 1u) * nx) xb_add(&bar[XB_TOPGEN], 1u);
            else XB_SPIN(xb_ld(&bar[XB_TOPGEN]) == tg, bar);
            __builtin_amdgcn_fence(__ATOMIC_ACQUIRE, "agent");
            xb_add(&bar[XB_XGEN(x)], 1u);
            asm volatile("s_waitcnt vmcnt(0)" ::: "memory");
        } else {
            XB_SPIN(xb_ld(&bar[XB_XGEN(x)]) == gen, bar);
            __builtin_amdgcn_fence(__ATOMIC_ACQUIRE, "agent");
            asm volatile("s_waitcnt vmcnt(0)" ::: "memory");
        }
    }
    __syncthreads();
}
__device__ __forceinline__ void run_phase(LAS unsigned char* lds, const Params& p, int code) {
    size_t zoff = 0; asm volatile("" : "+s"(zoff));
    unsigned char* ws = p.ws + zoff;
    const int layer = code >> 4, step = code & 15;
    const int kind = layer % 3, slot = layer / 3, sl_mix = 2 * layer, sl_ffn = 2 * layer + 1;
    float* vec = (float*)(ws + OFF_VEC);
    i64* stats = (i64*)(ws + OFF_STATS);
    const float* rope = (const float*)(ws + OFF_ROPE);
    float* Y = (float*)(ws + OFF_Y);
    bf16_t* YB = (bf16_t*)(ws + OFF_YB);
    bf16_t* QKV = (bf16_t*)(ws + OFF_QKV);
    bf16_t* OB = (bf16_t*)(ws + OFF_O);
    bf16_t* HID = (bf16_t*)(ws + OFF_HID);
    const i64* st_in = layer == 0 ? nullptr : stats + (size_t)(sl_mix - 1) * T_ * 2;
    const unsigned char* wm = ws + OFF_MLA + slot * MLA_SLOT;
    bf16_t* DOWN = (bf16_t*)((unsigned char*)QKV + QKV_DOWN); bf16_t* Qb = (bf16_t*)((unsigned char*)QKV + QKV_Q);
    bf16_t* KVb = (bf16_t*)((unsigned char*)QKV + QKV_KV); bf16_t* KRb = (bf16_t*)((unsigned char*)QKV + QKV_KR);
    i64* rowss = stats + ST_ROWSS + (size_t)slot * T_ * 2;
    pg8::StaticOrder S;
    switch (step) {
    case 0: phase_prep(lds, p); break;
    case 1: { pg8::Gemm g{YB, (const bf16_t*)(wm + MLA_DOWN), T_, 1280, DM, DM}; S.init(T_, 1280, lgdim(), lbid());
              EpiProj<0, 0> E{DOWN, 1280, st_in, 0, vec + V_MD_CS + slot * 1280, vec + V_MD_BW + slot * 1280, rowss};
              pg8::gemm_phase(lds, g, S, E); } break;
    case 2: { krope_phase(DOWN, rope, KRb);
              { pg8::Gemm g{DOWN, (const bf16_t*)(wm + MLA_UQ), T_, 3072, 512, 1280}; S.init(T_, 3072, lgdim(), lbid());
                EpiProj<2, 0> E{Qb, 3072, rowss, 0, nullptr, nullptr, nullptr};
                pg8::gemm_phase(lds, g, S, E); }
              { pg8::Gemm g{DOWN + 512, (const bf16_t*)(wm + MLA_UKV), T_, 4096, 512, 1280}; S.init(T_, 4096, lgdim(), lbid());
                EpiProj<2, 0> E{KVb, 4096, rowss, 1, nullptr, nullptr, nullptr};
                pg8::gemm_phase(lds, g, S, E); } } break;
    case 3: { AttnArgs a{Qb, KVb, KRb, rope, nullptr, OB}; attn_phase<0>(lds, a); } break;
    case 4: { const unsigned char* wq = ws + (kind == 1 ? OFF_SB : OFF_CA);
              pg8::Gemm g{YB, (const bf16_t*)wq, T_, 6144, DM, DM}; S.init(T_, 6144, lgdim(), lbid());
              EpiProj<0, 0> E{QKV, 6144, st_in, 0, vec + (kind == 1 ? V_SB_CS : V_CA_CS), vec + (kind == 1 ? V_SB_BW : V_CA_BW), nullptr};
              pg8::gemm_phase(lds, g, S, E); } break;
    case 5: { AttnArgs a{QKV, nullptr, nullptr, nullptr, nullptr, OB}; attn_phase<1>(lds, a); } break;
    case 6: { AttnArgs a{QKV, nullptr, nullptr, nullptr, p.in[16], OB}; attn_phase<2>(lds, a); } break;
    case 7: { const bf16_t* wo = (const bf16_t*)(kind == 0 ? ws + OFF_MLA + slot * MLA_SLOT + MLA_WO : (kind == 1 ? ws + OFF_SB + 24 * MB : ws + OFF_CA + 24 * MB));
              pg8::Gemm g{OB, wo, T_, DM, DM, DM}; S.init(T_, DM, lgdim(), lbid());
              const float* lg = layer == 0 ? nullptr : p.in[3] + (size_t)(layer - 1) * DM; const float* lb = layer == 0 ? nullptr : p.in[4] + (size_t)(layer - 1) * DM;
              EpiRes E{layer == 0 ? p.in[0] : Y, Y, YB, st_in, lg, lb, stats + (size_t)sl_mix * T_ * 2};
              pg8::gemm_phase(lds, g, S, E); } break;
    case 8: { pg8::Gemm g{YB, (const bf16_t*)(ws + OFF_WFI + (size_t)layer * 32 * MB), T_, DFF, DM, DM}; S.init(T_, DFF, lgdim(), lbid());
              EpiProj<0, 1> E{HID, DFF, stats + (size_t)sl_mix * T_ * 2, 0, vec + V_FI_CS + layer * 8192, vec + V_FI_BW + layer * 8192, nullptr};
              pg8::gemm_phase(lds, g, S, E); } break;
    case 9: { pg8::Gemm g{HID, (const bf16_t*)(ws + OFF_WFO + (size_t)layer * 32 * MB), T_, DM, DFF, DFF}; S.init(T_, DM, lgdim(), lbid());
              EpiRes E{Y, Y, YB, stats + (size_t)sl_mix * T_ * 2, p.in[1] + (size_t)layer * DM, p.in[2] + (size_t)layer * DM, stats + (size_t)sl_ffn * T_ * 2};
              pg8::gemm_phase(lds, g, S, E); } break;
    default: final_ln(Y, stats + (size_t)7 * T_ * 2, p.in[3] + 3 * DM, p.in[4] + 3 * DM, p.out); break;
    }
}

__global__ void __launch_bounds__(512, 2) fwd_megakernel(Params p) {
    extern __shared__ __attribute__((aligned(16))) unsigned char shm[];
    LAS unsigned char* lds = (LAS unsigned char*)shm;
    __builtin_assume(__builtin_amdgcn_workitem_id_y() == 0); __builtin_assume(__builtin_amdgcn_workitem_id_z() == 0);
    cg::grid_group grid = cg::this_grid();
    volatile LAS unsigned* st = (volatile LAS unsigned*)(lds + XB_ST_OFF);
    unsigned* bar = (unsigned*)(p.ws + OFF_BAR);
    if (threadIdx.x == 0) { st[0] = 0u; st[1] = 0u; }
    if (blockIdx.x == 0) for (int i = threadIdx.x; i < XCD_BAR_WORDS; i += 512) bar[i] = 0u;
    __syncthreads();
    for (int ph = p.ph_lo; ph < p.ph_hi; ++ph) {
        const int code = p.prog[ph];
        run_phase(lds, p, code);
        if (ph + 1 < p.ph_hi) {
            if (ph == p.ph_lo) { grid.sync(); if (threadIdx.x == 0) (void)xb_add(&bar[XB_XCNT(xb_xcc_id())], 1u); }
            else xcd_barrier((unsigned*)(p.ws + OFF_BAR), st); }
    }
}

constexpr int LDS_BYTES = 155648;

extern "C" void kernel_launch(void* const* d_in, const int* in_sizes, int n_in, void* d_out, int out_size, void* d_ws, size_t ws_size, hipStream_t stream) {
    static int grid_blocks = 0;
    if (!grid_blocks) {
        int dev = 0, cus = 0, per_cu = 0;
        hipGetDevice(&dev);
        hipDeviceGetAttribute(&cus, hipDeviceAttributeMultiprocessorCount, dev);
        hipFuncSetAttribute((const void*)fwd_megakernel, hipFuncAttributeMaxDynamicSharedMemorySize, LDS_BYTES);
        hipOccupancyMaxActiveBlocksPerMultiprocessor(&per_cu, (const void*)fwd_megakernel, 512, LDS_BYTES);
        if (per_cu < 1) per_cu = 1;
        grid_blocks = cus * per_cu;
        if (ws_size < WS_END) fprintf(stderr, "workspace too small: %zu < %zu\n", ws_size, (size_t)WS_END);
    }
    Params p{};
    for (int i = 0; i < 18; ++i) p.in[i] = (const float*)d_in[i];
    p.out = (float*)d_out; p.ws = (unsigned char*)d_ws;
    unsigned char* ws = (unsigned char*)d_ws; float* vec = (float*)(ws + OFF_VEC);
    int n = 0, items = 0;
    auto add = [&](const float* W, void* WT, const float* g, const float* bvec, float* csum, float* bw, int K, int N, int Npad, int kchunk) {
        WDesc& d = p.wd[n++]; d.W = W; d.WT = (bf16_t*)WT; d.g = g; d.bvec = bvec; d.csum = csum; d.bw = bw; d.K = K; d.N = N; d.Npad = Npad; d.kchunk = kchunk;
        d.item0 = items; d.nitems = (Npad / 128) * (K / kchunk); items += d.nitems; };
    for (int l = 0; l < 4; ++l) add(p.in[5] + (size_t)l * DM * DFF, ws + OFF_WFI + (size_t)l * 32 * MB, p.in[1] + l * DM, p.in[2] + l * DM, vec + V_FI_CS + l * 8192, vec + V_FI_BW + l * 8192, DM, DFF, DFF, DM);
    for (int l = 0; l < 4; ++l) add(p.in[6] + (size_t)l * DM * DFF, ws + OFF_WFO + (size_t)l * 32 * MB, nullptr, nullptr, nullptr, nullptr, DFF, DM, DM, 2048);
    add(p.in[13], ws + OFF_SB, p.in[3] + 0 * DM, p.in[4] + 0 * DM, vec + V_SB_CS, vec + V_SB_BW, DM, 6144, 6144, DM);
    add(p.in[15], ws + OFF_CA, p.in[3] + 1 * DM, p.in[4] + 1 * DM, vec + V_CA_CS, vec + V_CA_BW, DM, 6144, 6144, DM);
    add(p.in[14], ws + OFF_SB + 24 * MB, nullptr, nullptr, nullptr, nullptr, DM, DM, DM, DM);
    add(p.in[17], ws + OFF_CA + 24 * MB, nullptr, nullptr, nullptr, nullptr, DM, DM, DM, DM);
    for (int s = 0; s < 2; ++s) add(p.in[12] + (size_t)s * DM * DM, ws + OFF_MLA + s * MLA_SLOT + MLA_WO, nullptr, nullptr, nullptr, nullptr, DM, DM, DM, DM);
    add(p.in[7], ws + OFF_MLA + MLA_DOWN, nullptr, nullptr, nullptr, nullptr, DM, 1088, 1280, DM);
    add(p.in[7] + (size_t)DM * 1088, ws + OFF_MLA + MLA_SLOT + MLA_DOWN, p.in[3] + 2 * DM, p.in[4] + 2 * DM, vec + V_MD_CS + 1280, vec + V_MD_BW + 1280, DM, 1088, 1280, DM);
    for (int s = 0; s < 2; ++s) add(p.in[9] + (size_t)s * 512 * 3072, ws + OFF_MLA + s * MLA_SLOT + MLA_UQ, p.in[8] + s * 512, nullptr, nullptr, nullptr, 512, 3072, 3072, 512);
    for (int s = 0; s < 2; ++s) add(p.in[11] + (size_t)s * 512 * 4096, ws + OFF_MLA + s * MLA_SLOT + MLA_UKV, p.in[10] + s * 512, nullptr, nullptr, nullptr, 512, 4096, 4096, 512);
    p.nwd = n; p.total_items = items;
    int np = 0;
    p.prog[np++] = 0;
    for (int l = 0; l < 4; ++l) {
        const int kind = l % 3;
        if (kind == 0) { p.prog[np++] = (l << 4) | 1; p.prog[np++] = (l << 4) | 2; p.prog[np++] = (l << 4) | 3; }
        else { p.prog[np++] = (l << 4) | 4; p.prog[np++] = (l << 4) | (kind == 1 ? 5 : 6); }
        p.prog[np++] = (l << 4) | 7; p.prog[np++] = (l << 4) | 8; p.prog[np++] = (l << 4) | 9;
    }
    p.prog[np++] = 10;
    p.ph_lo = 0; p.ph_hi = np;
    void* args[] = {&p};
    hipError_t e = hipLaunchCooperativeKernel((const void*)fwd_megakernel, dim3(grid_blocks), dim3(512), args, LDS_BYTES, stream);
    if (e != hipSuccess) fprintf(stderr, "cooperative launch failed: %s (grid %d)\n", hipGetErrorString(e), grid_blocks);
}
```
